# Optimizing an MI355X kernel written in HIP

```python
import math
import jax, jax.numpy as jnp
from jax import lax
import numpy as np

D_MODEL = 1024
BATCH = 8
SEQ = 2048
DEPTH = 1

MLA_HEADS = 8
MLA_NOPE_DIM = 64
MLA_ROPE_DIM = 32
MLA_QK_DIM = MLA_NOPE_DIM + MLA_ROPE_DIM
MLA_V_DIM = 64
MLA_WIDTH = MLA_HEADS * MLA_V_DIM
MLA_Q_RANK = 384
MLA_KV_RANK = 256
ROPE_THETA = 10000.0
Q_BLOCK = 128
GLA_HEADS = 4
GLA_DV = D_MODEL // 2
GLA_DK = GLA_DV // 2
GLA_HEAD_K = GLA_DK // GLA_HEADS
GLA_HEAD_V = GLA_DV // GLA_HEADS
GLA_GATE_RANK = 16
GLA_GATE_TAU = 16.0
GLA_CHUNK = 64
D_FF = -(-8 * D_MODEL // (3 * 256)) * 256
NORM_EPS = 1e-6
IN_SIZES = (MLA_Q_RANK, MLA_KV_RANK, MLA_ROPE_DIM,
            GLA_DK, GLA_DK, GLA_DV, GLA_GATE_RANK, GLA_DV,
            D_MODEL, D_MODEL)
D_IN = sum(IN_SIZES)

kernel_name = "hybrid_mla_gla_gated_block"


def rmsnorm(x, w):
    xf = x.astype(jnp.float32)
    y = xf * lax.rsqrt(jnp.mean(xf * xf, axis=-1, keepdims=True) + NORM_EPS)
    return (y * w.astype(jnp.float32)).astype(x.dtype)


def rope_tables(positions):
    half = MLA_ROPE_DIM // 2
    inv = 1.0 / (ROPE_THETA ** (jnp.arange(half, dtype=jnp.float32) / half))
    ang = positions.astype(jnp.float32)[..., None] * inv
    return jnp.cos(ang), jnp.sin(ang)


def apply_rope(x, cos, sin):
    x1, x2 = jnp.split(x.astype(jnp.float32), 2, axis=-1)
    return jnp.concatenate([x1 * cos - x2 * sin, x2 * cos + x1 * sin], axis=-1).astype(x.dtype)


def mla(c_q, c_kv, k_rope, cos, sin, norm_cq, w_uq, norm_ckv, w_ukv):
    B, S, _ = c_q.shape
    H = MLA_HEADS
    q = (rmsnorm(c_q, norm_cq) @ w_uq).reshape(B, S, H, MLA_QK_DIM)
    q_nope, q_rope = q[..., :MLA_NOPE_DIM], q[..., MLA_NOPE_DIM:]
    q_rope = apply_rope(q_rope, cos[:, :, None], sin[:, :, None])
    kv = (rmsnorm(c_kv, norm_ckv) @ w_ukv).reshape(B, S, H, MLA_NOPE_DIM + MLA_V_DIM)
    k_nope, v = kv[..., :MLA_NOPE_DIM], kv[..., MLA_NOPE_DIM:]
    k_rope = apply_rope(k_rope, cos, sin)
    k = jnp.concatenate([k_nope, jnp.broadcast_to(k_rope[:, :, None], (B, S, H, MLA_ROPE_DIM)).astype(k_nope.dtype)], axis=-1)
    q = jnp.concatenate([q_nope, q_rope], axis=-1) * (MLA_QK_DIM ** -0.5)
    nb = S // Q_BLOCK
    q_blocks = q.reshape(B, nb, Q_BLOCK, H, MLA_QK_DIM).transpose(1, 0, 2, 3, 4)
    key_idx = jnp.arange(S)

    def attend(args):
        q_blk, start = args
        s = jnp.einsum('bqhd,bkhd->bhqk', q_blk, k).astype(jnp.float32)
        q_idx = start + jnp.arange(Q_BLOCK)
        mask = key_idx[None, :] <= q_idx[:, None]
        s = jnp.where(mask, s, -jnp.inf)
        p = jax.nn.softmax(s, axis=-1).astype(v.dtype)
        return jnp.einsum('bhqk,bkhd->bqhd', p, v)

    o = lax.map(attend, (q_blocks, jnp.arange(nb) * Q_BLOCK))
    return o.transpose(1, 0, 2, 3, 4).reshape(B, S, MLA_WIDTH)


def gla(q, k, v, g_lr, og, w_gate2, b_gate, norm_o):
    B, S, _ = q.shape
    H, C = GLA_HEADS, GLA_CHUNK
    n = S // C
    log_a = jax.nn.log_sigmoid((g_lr @ w_gate2 + b_gate).astype(jnp.float32)) / GLA_GATE_TAU

    def heads(t, d):
        return t.reshape(B, S, H, d).transpose(0, 2, 1, 3).astype(jnp.float32)

    def chunks(t):
        return t.reshape(B, H, n, C, t.shape[-1]).transpose(2, 0, 1, 3, 4)

    qh = heads(q, GLA_HEAD_K) * (GLA_HEAD_K ** -0.5)
    kh = heads(k, GLA_HEAD_K)
    vh = heads(v, GLA_HEAD_V)
    gh = heads(log_a, GLA_HEAD_K)
    bcum = jnp.cumsum(chunks(gh), axis=3)
    causal = jnp.tril(jnp.ones((C, C), dtype=bool))

    def step(state, xs):
        qc, kc, vc, bc = xs
        o_inter = jnp.einsum('bhcd,bhde->bhce', qc * jnp.exp(bc), state)
        diff = bc[:, :, :, None, :] - bc[:, :, None, :, :]
        decay = jnp.exp(jnp.where(causal[:, :, None], diff, -jnp.inf))
        attn = jnp.einsum('bhid,bhjd,bhijd->bhij', qc, kc, decay)
        o_intra = jnp.einsum('bhij,bhje->bhie', attn, vc)
        b_last = bc[:, :, -1:, :]
        k_dec = kc * jnp.exp(b_last - bc)
        state = jnp.exp(b_last[:, :, 0, :])[..., None] * state + jnp.einsum('bhcd,bhce->bhde', k_dec, vc)
        return state, o_inter + o_intra

    state0 = jnp.zeros((B, H, GLA_HEAD_K, GLA_HEAD_V), jnp.float32)
    _, o = lax.scan(step, state0, (chunks(qh), chunks(kh), chunks(vh), bcum))
    o = o.transpose(1, 0, 3, 2, 4).reshape(B, S, H, GLA_HEAD_V)
    o = rmsnorm(o, norm_o).reshape(B, S, GLA_DV)
    o = o * jax.nn.silu(og.astype(jnp.float32))
    return o.astype(q.dtype)


def setup_inputs(seed: int = 0) -> dict:
    key = jax.random.key(seed)
    ks = jax.random.split(key, 24)
    L, D = DEPTH, D_MODEL

    def w(k, shape, fan_in):
        return jax.random.normal(k, shape, jnp.float32) * (fan_in ** -0.5)

    def gain(k, shape):
        return 1.0 + 0.02 * jax.random.normal(k, shape, jnp.float32)

    return {
        "x": jax.random.normal(ks[0], (BATCH, SEQ, D), jnp.float32),
        "positions": jnp.broadcast_to(jnp.arange(SEQ, dtype=jnp.int32), (BATCH, SEQ)),
        "ln_mix": gain(ks[1], (L, D)),
        "w_in": w(ks[2], (L, D, D_IN), D),
        "mla_norm_cq": gain(ks[3], (L, MLA_Q_RANK)),
        "mla_w_uq": w(ks[4], (L, MLA_Q_RANK, MLA_HEADS * MLA_QK_DIM), MLA_Q_RANK),
        "mla_norm_ckv": gain(ks[5], (L, MLA_KV_RANK)),
        "mla_w_ukv": w(ks[6], (L, MLA_KV_RANK, MLA_HEADS * (MLA_NOPE_DIM + MLA_V_DIM)), MLA_KV_RANK),
        "mla_w_o": w(ks[7], (L, MLA_WIDTH, D), MLA_WIDTH),
        "gla_w_gate2": w(ks[8], (L, GLA_GATE_RANK, GLA_DK), GLA_GATE_RANK),
        "gla_b_gate": 0.1 * jax.random.normal(ks[9], (L, GLA_DK), jnp.float32),
        "gla_norm": gain(ks[10], (L, GLA_HEAD_V)),
        "gla_w_o": w(ks[11], (L, GLA_DV, D), GLA_DV),
        "w_out": w(ks[12], (L, D, D), D),
        "ln_ffn": gain(ks[13], (L, D)),
        "ffn_w_gate": w(ks[14], (L, D, D_FF), D),
        "ffn_w_up": w(ks[15], (L, D, D_FF), D),
        "ffn_w_down": w(ks[16], (L, D_FF, D), D_FF),
        "final_norm": gain(ks[17], (D,)),
    }


def reference(x, positions, ln_mix, w_in, mla_norm_cq, mla_w_uq, mla_norm_ckv, mla_w_ukv, mla_w_o,
              gla_w_gate2, gla_b_gate, gla_norm, gla_w_o, w_out, ln_ffn, ffn_w_gate, ffn_w_up,
              ffn_w_down, final_norm):
    offsets = np.cumsum(IN_SIZES)[:-1].tolist()
    cos, sin = rope_tables(positions)
    h = x
    for l in range(DEPTH):
        u = rmsnorm(h, ln_mix[l])
        z = u @ w_in[l]
        c_q, c_kv, k_rope, g_q, g_k, g_v, g_lr, g_og, gate_a, gate_b = jnp.split(z, offsets, axis=-1)
        y_a = mla(c_q, c_kv, k_rope, cos, sin, mla_norm_cq[l], mla_w_uq[l], mla_norm_ckv[l], mla_w_ukv[l]) @ mla_w_o[l]
        y_b = gla(g_q, g_k, g_v, g_lr, g_og, gla_w_gate2[l], gla_b_gate[l], gla_norm[l]) @ gla_w_o[l]
        mix = jax.nn.sigmoid(gate_a) * y_a + jax.nn.sigmoid(gate_b) * y_b
        h = h + mix @ w_out[l]
        u = rmsnorm(h, ln_ffn[l])
        h = h + (jax.nn.silu(u @ ffn_w_gate[l]) * (u @ ffn_w_up[l])) @ ffn_w_down[l]
    return rmsnorm(h, final_norm)
```

```cpp
#include <hip/hip_runtime.h>
#include <hip/hip_cooperative_groups.h>
#include <cstdio>
#include <cstdint>
namespace cg = cooperative_groups;
namespace pg8 {
#define PG8_LAS __attribute__((address_space(3)))
typedef unsigned short bf16_t;
typedef short bf16x8 __attribute__((ext_vector_type(8)));
typedef float f32x4 __attribute__((ext_vector_type(4)));
typedef unsigned u32x4 __attribute__((ext_vector_type(4)));
constexpr int BM = 256, BK = 64, HALF = 128, HTB = HALF * BK * 2  , STAGE_BYTES = 8 * HTB, NXCD = 8, WGM = 4;

__host__ __device__ __forceinline__ int lds_byte(int r, int c) { const int st = (r >> 4) * 2 + (c >> 5), rr = r & 15, cc = c & 31, ob = rr * 64 + cc * 2; return st * 1024 + (ob ^ (((ob >> 9) & 1) << 5)); }
__host__ __device__ __forceinline__ void stage_rc(int b, int& R, int& C) { const int st = b / 1024, sb = b % 1024, swz = sb ^ (((sb >> 9) & 1) << 5); R = (st >> 1) * 16 + swz / 64; C = (st & 1) * 32 + (swz % 64) / 2; }
__host__ __device__ __forceinline__ int perm32(int rho) { const int n = rho >> 4, i = rho & 15; return 8 * (i >> 2) + 4 * n + (i & 3); }

struct Unit { int pm, pn, kh; };
struct Gemm { const bf16_t* A; const bf16_t* Bt; int M, N, K, lda, ldb; };

struct StaticOrder {
    int nM, nN, nwg, G, c;
    __host__ __device__ void init(int M, int N, int G_, int c_) { nM = M / BM; nN = N / BM; nwg = nM * nN; G = G_; c = c_; }
    __host__ __device__ bool next(int i, Unit& u) const {
        const long L = (long)i * G + c; if (L >= nwg) return false;
        int wgid = (int)L; { const int q = nwg / NXCD, r = nwg % NXCD, xcd = wgid % NXCD, off = wgid / NXCD; wgid = (xcd < r ? xcd * (q + 1) : r * (q + 1) + (xcd - r) * q) + off; }
        const int nig = WGM * nN, gid = wgid / nig, fm = gid * WGM, gsz = (nM - fm) < WGM ? (nM - fm) : WGM;
        u.pm = fm + ((wgid % nig) % gsz); u.pn = (wgid % nig) / gsz; return true;
    }
    __device__ __forceinline__ void a_ready(const Unit&) const {}
    __device__ __forceinline__ void done(const Unit&) const {}
};

__device__ __forceinline__ unsigned cvt_pk_bf16(float lo, float hi) { unsigned r; asm volatile("v_cvt_pk_bf16_f32 %0, %1, %2" : "=v"(r) : "v"(lo), "v"(hi)); return r; }
template <class Epi, class Sched, bool ALIGN_EPI = false, bool SP2 = false, bool KSPLIT = false>
__device__ __forceinline__ void gemm_phase(PG8_LAS unsigned char* lds, const Gemm g, const Sched& S, const Epi& E) {
    const int tid = threadIdx.x, wid = __builtin_amdgcn_readfirstlane(tid >> 6), lane = tid & 63, wr = wid >> 2, wc = wid & 3, fr = lane & 15, fq = lane >> 4;
    const int K = g.K, nt = K / BK;
    unsigned voffA[2], voffB[2];
#pragma unroll
    for (int i = 0; i < 2; ++i) { int R, C; stage_rc(tid * 16 + i * 8192, R, C); const int Rb = Epi::PERM ? ((R & ~31) + perm32(R & 31)) : R;
        voffA[i] = (unsigned)(R * g.lda + C) * 2u; voffB[i] = (unsigned)(Rb * g.ldb + C) * 2u; }
    const size_t kstep = (size_t)(BK * 2);
    const size_t hstepA = (size_t)HALF * g.lda * 2, hstepB = (size_t)HALF * g.ldb * 2;
    const size_t tstepA = 2 * hstepA, tstepB = 2 * hstepB;
    const unsigned ldsw = (unsigned)wid * 1024u;
    const int aoff = lds_byte(wr * 64 + fr, fq * 8), boff = lds_byte(wc * 32 + fr, fq * 8);
#define PG8_SA(b, h) (((b) * 2 + (h)) * HTB)
#define PG8_SB(b, h) ((4 + (b) * 2 + (h)) * HTB)
#define PG8_STAGE(bufoff, gbase, voff) do { _Pragma("unroll") for (int _i = 0; _i < 2; ++_i) \
        __builtin_amdgcn_global_load_lds((const unsigned*)((const char*)(gbase) + (voff)[_i]), (PG8_LAS unsigned*)(lds + (bufoff) + ldsw + _i * 8192), 16, 0, 0); } while (0)
#define PG8_LDA(dst, b, h) do { _Pragma("unroll") for (int m = 0; m < 4; ++m) _Pragma("unroll") for (int k = 0; k < 2; ++k) dst[m][k] = *(const PG8_LAS bf16x8*)(lds + PG8_SA(b, h) + aoff + m * 2048 + k * 1024); } while (0)
#define PG8_LDB(dst, b, h) do { _Pragma("unroll") for (int n = 0; n < 2; ++n) _Pragma("unroll") for (int k = 0; k < 2; ++k) dst[n][k] = *(const PG8_LAS bf16x8*)(lds + PG8_SB(b, h) + boff + n * 2048 + k * 1024); } while (0)
#define PG8_MMA(ai, bj, At, Bt) do { __builtin_amdgcn_s_setprio(1); _Pragma("unroll") for (int m = 0; m < 4; ++m) _Pragma("unroll") for (int n = 0; n < 2; ++n) _Pragma("unroll") for (int k = 0; k < 2; ++k) \
        acc[ai][bj][m][n] = __builtin_amdgcn_mfma_f32_16x16x32_bf16(Bt[n][k], At[m][k], acc[ai][bj][m][n], 0, 0, 0); __builtin_amdgcn_s_setprio(0); } while (0)
#define PG8_WAIT_V(n) asm volatile("s_waitcnt vmcnt(" #n ")" ::: "memory")
#define PG8_WAIT_L(n) asm volatile("s_waitcnt lgkmcnt(" #n ")" ::: "memory")
#define PG8_BAR __builtin_amdgcn_s_barrier()
#define PG8_SCHED __builtin_amdgcn_sched_barrier(0)
    Unit cur, nxt; int ui = 0;
#define PG8_NEXT(j, u) (KSPLIT ? (u.kh = (j) & 1, S.next((j) >> 1, u)) : (u.kh = 0, S.next((j), u)))
    if (!PG8_NEXT(0, cur)) return;
    f32x4 acc[2][2][4][2];
#pragma unroll
    for (int a = 0; a < 2; ++a)
#pragma unroll
        for (int b = 0; b < 2; ++b)
#pragma unroll
            for (int m = 0; m < 4; ++m)
#pragma unroll
                for (int n = 0; n < 2; ++n) acc[a][b][m][n] = (f32x4){0.f, 0.f, 0.f, 0.f};
    bf16x8 At[4][2], B0[2][2], B1[2][2];
    const char* cA = (const char*)g.A + (size_t)cur.pm * tstepA + (size_t)cur.kh * K * 2; const char* cB = (const char*)g.Bt + (size_t)cur.pn * tstepB + (size_t)cur.kh * K * 2;
    S.a_ready(cur);
    if constexpr (SP2) {
        PG8_STAGE(PG8_SB(0, 0), cB, voffB); PG8_STAGE(PG8_SB(0, 1), cB + hstepB, voffB); PG8_STAGE(PG8_SA(0, 0), cA, voffA); PG8_STAGE(PG8_SA(0, 1), cA + hstepA, voffA);
        if (wr == 1) PG8_BAR;
        PG8_WAIT_V(2); PG8_BAR;
        PG8_STAGE(PG8_SB(1, 0), cB + kstep, voffB); PG8_STAGE(PG8_SA(1, 0), cA + kstep, voffA); PG8_STAGE(PG8_SB(1, 1), cB + hstepB + kstep, voffB);
        PG8_WAIT_V(6); PG8_BAR;
    } else {
        PG8_STAGE(PG8_SB(0, 0), cB, voffB); PG8_STAGE(PG8_SA(0, 0), cA, voffA); PG8_STAGE(PG8_SB(0, 1), cB + hstepB, voffB); PG8_STAGE(PG8_SA(0, 1), cA + hstepA, voffA);
        if (wr == 1) PG8_BAR;
        PG8_WAIT_V(4); PG8_BAR;
        PG8_STAGE(PG8_SB(1, 0), cB + kstep, voffB); PG8_STAGE(PG8_SA(1, 0), cA + kstep, voffA); PG8_STAGE(PG8_SB(1, 1), cB + hstepB + kstep, voffB);
        PG8_WAIT_V(6); PG8_BAR;
    }
    for (;;) {
        const bool has_next = PG8_NEXT(ui + 1, nxt);
        const char* nA = has_next ? (const char*)g.A + (size_t)nxt.pm * tstepA + (size_t)nxt.kh * K * 2 : cA; const char* nB = has_next ? (const char*)g.Bt + (size_t)nxt.pn * tstepB + (size_t)nxt.kh * K * 2 : cB;
        for (int t = 0; t < nt; t += 2) {
            const bool last = (t == nt - 2);
            const char* a1 = cA + (size_t)(t + 1) * kstep;
            const char* a2 = last ? nA : cA + (size_t)(t + 2) * kstep; const char* b2 = last ? nB : cB + (size_t)(t + 2) * kstep;
            const char* a3 = a2 + kstep; const char* b3 = b2 + kstep;
            if (last && has_next) S.a_ready(nxt);
            if constexpr (SP2) {
            PG8_LDB(B0, 0, 0); PG8_LDB(B1, 0, 1); PG8_SCHED; PG8_LDA(At, 0, 0); PG8_STAGE(PG8_SA(1, 1), a1 + hstepA, voffA);
            PG8_WAIT_V(8); PG8_WAIT_L(0); PG8_BAR; PG8_MMA(0, 0, At, B0); PG8_MMA(0, 1, At, B1); PG8_BAR; PG8_SCHED;
            PG8_LDA(At, 0, 1); PG8_STAGE(PG8_SB(0, 0), b2, voffB); PG8_STAGE(PG8_SB(0, 1), b2 + hstepB, voffB); PG8_STAGE(PG8_SA(0, 0), a2, voffA);
            PG8_WAIT_V(8); PG8_WAIT_L(0); PG8_BAR; PG8_MMA(1, 0, At, B0); PG8_MMA(1, 1, At, B1); PG8_BAR; PG8_SCHED;
            PG8_LDB(B0, 1, 0); PG8_LDB(B1, 1, 1); PG8_SCHED; PG8_LDA(At, 1, 0); PG8_STAGE(PG8_SA(0, 1), a2 + hstepA, voffA);
            PG8_WAIT_V(8); PG8_WAIT_L(0); PG8_BAR; PG8_MMA(0, 0, At, B0); PG8_MMA(0, 1, At, B1); PG8_BAR; PG8_SCHED;
            PG8_LDA(At, 1, 1); PG8_STAGE(PG8_SB(1, 0), b3, voffB); PG8_STAGE(PG8_SB(1, 1), b3 + hstepB, voffB); PG8_STAGE(PG8_SA(1, 0), a3, voffA);
            PG8_WAIT_V(8); PG8_WAIT_L(0); PG8_BAR; PG8_MMA(1, 0, At, B0); PG8_MMA(1, 1, At, B1); PG8_BAR; PG8_SCHED;
            } else {
            PG8_LDB(B0, 0, 0); PG8_SCHED; PG8_LDA(At, 0, 0); PG8_STAGE(PG8_SA(1, 1), a1 + hstepA, voffA);
            PG8_WAIT_L(8); PG8_BAR; PG8_WAIT_L(0); PG8_MMA(0, 0, At, B0); PG8_BAR; PG8_SCHED;
            PG8_LDB(B1, 0, 1); PG8_STAGE(PG8_SB(0, 0), b2, voffB);
            PG8_BAR; PG8_WAIT_L(0); PG8_MMA(0, 1, At, B1); PG8_BAR;
            PG8_LDA(At, 0, 1); PG8_STAGE(PG8_SA(0, 0), a2, voffA);
            PG8_BAR; PG8_WAIT_L(0); PG8_MMA(1, 0, At, B0); PG8_BAR; PG8_SCHED;
            PG8_STAGE(PG8_SB(0, 1), b2 + hstepB, voffB);
            PG8_WAIT_V(6); PG8_BAR; PG8_MMA(1, 1, At, B1); PG8_BAR;
            PG8_LDB(B0, 1, 0); PG8_SCHED; PG8_LDA(At, 1, 0); PG8_STAGE(PG8_SA(0, 1), a2 + hstepA, voffA);
            PG8_WAIT_L(8); PG8_BAR; PG8_WAIT_L(0); PG8_MMA(0, 0, At, B0); PG8_BAR; PG8_SCHED;
            PG8_LDB(B1, 1, 1); PG8_STAGE(PG8_SB(1, 0), b3, voffB);
            PG8_BAR; PG8_WAIT_L(0); PG8_MMA(0, 1, At, B1); PG8_BAR;
            PG8_LDA(At, 1, 1); PG8_STAGE(PG8_SA(1, 0), a3, voffA);
            PG8_BAR; PG8_WAIT_L(0); PG8_MMA(1, 0, At, B0); PG8_BAR; PG8_SCHED;
            PG8_STAGE(PG8_SB(1, 1), b3 + hstepB, voffB);
            PG8_WAIT_V(6); PG8_BAR; PG8_MMA(1, 1, At, B1); PG8_BAR;
            }
        }
        if constexpr (ALIGN_EPI) { if (wr == 0) PG8_BAR; }
        if constexpr (KSPLIT) { if (cur.kh == 0) E.mid(acc, cur, wr, wc, fr, fq); else E(acc, cur, wr, wc, fr, fq); }
        else if constexpr (!Epi::AFTER_DRAIN) { E(acc, cur, wr, wc, fr, fq); S.done(cur); }
        if (!has_next) break;
        if (!KSPLIT || cur.kh == 1)
#pragma unroll
        for (int a = 0; a < 2; ++a)
#pragma unroll
            for (int b = 0; b < 2; ++b)
#pragma unroll
                for (int m = 0; m < 4; ++m)
#pragma unroll
                    for (int n = 0; n < 2; ++n) acc[a][b][m][n] = (f32x4){0.f, 0.f, 0.f, 0.f};
        cur = nxt; cA = nA; cB = nB; ++ui;
        if constexpr (ALIGN_EPI) { if (wr == 1) PG8_BAR; }
    }
    PG8_WAIT_V(0);
    if constexpr (!ALIGN_EPI) { if (wr == 0) PG8_BAR; }
    PG8_BAR;
    if constexpr (Epi::AFTER_DRAIN) { E.fused(acc, cur, wr, wc, fr, fq, lds, wid, lane); S.done(cur); }
#undef PG8_NEXT
#undef PG8_SA
#undef PG8_SB
#undef PG8_STAGE
#undef PG8_LDA
#undef PG8_LDB
#undef PG8_MMA
#undef PG8_WAIT_V
#undef PG8_WAIT_L
#undef PG8_BAR
#undef PG8_SCHED
}
}

#define DI __device__ __forceinline__
#define LAS __attribute__((address_space(3)))
typedef unsigned short bf16_t;
typedef short bf16x8 __attribute__((ext_vector_type(8)));
typedef short s16x4 __attribute__((ext_vector_type(4)));
typedef float f32x4 __attribute__((ext_vector_type(4)));
typedef float f32x2 __attribute__((ext_vector_type(2)));
typedef float f32x16 __attribute__((ext_vector_type(16)));
typedef unsigned u32x4 __attribute__((ext_vector_type(4)));
typedef unsigned u32x2 __attribute__((ext_vector_type(2)));

constexpr int NTOK = 16384, SEQ = 2048, NBATCH = 8, DM = 1024, DIN = 4272, NIN = 4352, ZP = 2304, DFF = 2816;
constexpr int ZC_CQ = 0, ZC_CKV = 384, ZC_KR = 640, ZC_GQ = 672, ZC_GK = 928, ZC_GV = 1184, ZC_GLR = 1696, ZC_OG = 1712, ZC_GA = 2224, ZC_GB = 3248;
constexpr float EPS = 1e-6f;
constexpr float QSCALE = 0.10206207261596575f * 1.4426950408889634f;
constexpr int NTHREADS = 512, NPHASE = 9;
constexpr int LDS_BYTES = 139264;
constexpr size_t MiB = 1u << 20;
constexpr size_t WS_SS = 0;
constexpr size_t WS_DEC = 512 * 1024;
constexpr size_t WS_BAR = 768 * 1024;
constexpr size_t WS_COS = 1 * MiB, WS_SIN = 2 * MiB, WS_KR = 3 * MiB;
constexpr size_t WS_WIN = 4 * MiB, WS_WUQ = 13 * MiB, WS_WUKV = 14 * MiB, WS_WOA = 15 * MiB, WS_WOB = 16 * MiB, WS_WOUT = 17 * MiB, WS_WGU = 19 * MiB, WS_WD = 30 * MiB;
constexpr size_t WS_Z = 36 * MiB;
constexpr size_t WS_RB = 108 * MiB, WS_SB = 140 * MiB;
constexpr size_t WS_U = 172 * MiB;
constexpr size_t WS_KV = 204 * MiB;
constexpr size_t WS_OM = 236 * MiB;
constexpr size_t WS_END = 252 * MiB;

DI unsigned pk2(float lo, float hi) { typedef __bf16 bf2 __attribute__((ext_vector_type(2))); f32x2 v = {lo, hi}; bf2 b = __builtin_convertvector(v, bf2); return __builtin_bit_cast(unsigned, b); }
DI float bflo(unsigned u) { return __uint_as_float(u << 16); }
DI float bfhi(unsigned u) { return __uint_as_float(u & 0xffff0000u); }
DI float bf2f(bf16_t v) { return __uint_as_float((unsigned)v << 16); }
DI float sigmoidf_(float x) { return __builtin_amdgcn_rcpf(1.0f + __expf(-x)); }
DI float sum_fq(float v) {
    const auto a = __builtin_amdgcn_permlane16_swap(__float_as_uint(v), __float_as_uint(v), false, false); v = __uint_as_float(a[0]) + __uint_as_float(a[1]);
    const auto b = __builtin_amdgcn_permlane32_swap(__float_as_uint(v), __float_as_uint(v), false, false); return __uint_as_float(b[0]) + __uint_as_float(b[1]);
}
DI float sum_half(float v) { const auto b = __builtin_amdgcn_permlane32_swap(__float_as_uint(v), __float_as_uint(v), false, false); return __uint_as_float(b[0]) + __uint_as_float(b[1]); }
DI float ld_agent(const float* p) { return __hip_atomic_load(p, __ATOMIC_RELAXED, __HIP_MEMORY_SCOPE_AGENT); }
DI void add_agent(float* p, float v) { (void)__hip_atomic_fetch_add(p, v, __ATOMIC_RELAXED, __HIP_MEMORY_SCOPE_AGENT); }
DI s16x4 tr_read(const bf16_t* p) { typedef short v4i16 __attribute__((ext_vector_type(4))); return __builtin_bit_cast(s16x4, __builtin_amdgcn_ds_read_tr16_b64_v4i16((LAS v4i16*)(p))); }
DI bf16x8 cat8(s16x4 a, s16x4 b) { return (bf16x8){a[0], a[1], a[2], a[3], b[0], b[1], b[2], b[3]}; }
#define MFMA32(a, b, c) __builtin_amdgcn_mfma_f32_32x32x16_bf16((a), (b), (c), 0, 0, 0)
DI bf16x8 pack8(float a0, float a1, float a2, float a3, float a4, float a5, float a6, float a7) {
    u32x4 p; p[0] = pk2(a0, a1); p[1] = pk2(a2, a3); p[2] = pk2(a4, a5); p[3] = pk2(a6, a7); return __builtin_bit_cast(bf16x8, p); }

struct Params {
    const float* x; const int* pos; const float* ln_mix; const float* w_in; const float* norm_cq; const float* w_uq; const float* norm_ckv; const float* w_ukv;
    const float* w_oa; const float* w_gate2; const float* b_gate; const float* gla_norm; const float* w_ob; const float* w_out; const float* ln_ffn;
    const float* w_fg; const float* w_fu; const float* w_fd; const float* final_norm;
    float* out; unsigned char* ws; int ph_lo, ph_hi;
};

#define XB_TMO      128
#define XB_XCNT(j)  (256  + 64 * (j))
#define XB_XSUB(j)  (1280 + 64 * (j))
#define XB_XGEN(j)  (2304 + 64 * (j))
#define XB_TOP      3328
#define XB_TOPGEN   3392
#define XCD_BAR_WORDS 3456
#define XB_SPIN_CAP (1u << 20)
DI unsigned xb_ld(unsigned* p)              { return __hip_atomic_load(p, __ATOMIC_RELAXED, __HIP_MEMORY_SCOPE_AGENT); }
DI unsigned xb_add(unsigned* p, unsigned v) { return __hip_atomic_fetch_add(p, v, __ATOMIC_RELAXED, __HIP_MEMORY_SCOPE_AGENT); }
DI unsigned xb_xcc_id() { return (unsigned)__builtin_amdgcn_s_getreg((3 << 11) | 20) & 0xFu; }
#define XB_SPIN(cond, bar) do { unsigned _sp = 0; while (cond) { \
    if ((++_sp & 255u) == 0u) { if (xb_ld(&(bar)[XB_TMO])) break; if (_sp > XB_SPIN_CAP) { atomicAdd(&(bar)[XB_TMO], 1u); break; } } } } while (0)
struct XcdBarrier { unsigned* bar; unsigned x; volatile LAS unsigned* st; };
DI XcdBarrier xcd_barrier_post(unsigned* bar, volatile LAS unsigned* st) {
    XcdBarrier b; b.bar = bar; b.x = xb_xcc_id(); b.st = st;
    if (threadIdx.x == 0) (void)xb_add(&bar[XB_XCNT(b.x)], 1u);
    return b;
}
DI void xcd_barrier_complete(unsigned* bar, unsigned x, unsigned& nloc, unsigned& nx) {
    const unsigned G = gridDim.x * gridDim.y * gridDim.z;
    unsigned sum, cnt, mine, sp = 0u;
    for (;;) {
        sum = 0u; cnt = 0u; mine = 0u;
#pragma unroll
        for (unsigned j = 0; j < 16; ++j) { const unsigned c = xb_ld(&bar[XB_XCNT(j)]); sum += c; cnt += (c > 0u) ? 1u : 0u; mine = (j == x) ? c : mine; }
        if (sum == G) break;
        __builtin_amdgcn_s_sleep(1);
        if ((++sp & 255u) == 0u) { if (xb_ld(&bar[XB_TMO])) break; if (sp > XB_SPIN_CAP) { atomicAdd(&bar[XB_TMO], 1u); break; } }
    }
    nloc = mine > 0u ? mine : 1u; nx = cnt > 0u ? cnt : 1u;
}
DI void xcd_barrier(const XcdBarrier& b) {
    asm volatile("s_waitcnt vmcnt(0)" ::: "memory");
    __syncthreads();
    if (threadIdx.x == 0) {
        unsigned* bar = b.bar;
        __builtin_amdgcn_s_waitcnt(0);
        unsigned nloc = b.st[0], nx = b.st[1];
        if (nloc == 0u) { xcd_barrier_complete(bar, b.x, nloc, nx); b.st[0] = nloc; b.st[1] = nx; }
        const unsigned old = xb_add(&bar[XB_XSUB(b.x)], 1u);
        const unsigned gen = old / nloc;
        if (old + 1u == (gen + 1u) * nloc) {
            __builtin_amdgcn_fence(__ATOMIC_RELEASE, "agent");
            asm volatile("s_waitcnt vmcnt(0)" ::: "memory");
            const unsigned og = xb_add(&bar[XB_TOP], 1u);
            const unsigned tg = og / nx;
            if (og + 1u == (tg + 1u) * nx) xb_add(&bar[XB_TOPGEN], 1u);
            else XB_SPIN(xb_ld(&bar[XB_TOPGEN]) == tg, bar);
            __builtin_amdgcn_fence(__ATOMIC_ACQUIRE, "agent");
            xb_add(&bar[XB_XGEN(b.x)], 1u);
            asm volatile("s_waitcnt vmcnt(0)" ::: "memory");
        } else {
            XB_SPIN(xb_ld(&bar[XB_XGEN(b.x)]) == gen, bar);
            __builtin_amdgcn_fence(__ATOMIC_ACQUIRE, "agent");
            asm volatile("s_waitcnt vmcnt(0)" ::: "memory");
        }
    }
    __syncthreads();
}

using pg8::Unit;
struct EpiZ {
    static constexpr bool PERM = true, AFTER_DRAIN = false, HAS_MID = false;
    bf16_t* Z; float* ssq; float* sskv; bf16_t* RB; bf16_t* SB;
    DI void operator()(const f32x4 (&acc)[2][2][4][2], const Unit& u, int wr, int wc, int fr, int fq) const {
        const int row0 = u.pm * 256 + wr * 64 + fr, col0 = u.pn * 256 + wc * 32 + 8 * fq;
        if (u.pn >= 9) {
            const int gcol = (u.pn - 9) * 128 + wc * 32 + 8 * fq;
#pragma unroll
            for (int ai = 0; ai < 2; ++ai)
#pragma unroll
                for (int m = 0; m < 4; ++m) {
                    const size_t off = (size_t)(row0 + ai * 128 + m * 16) * 1024 + gcol;
                    float rr[8], sb[8];
#pragma unroll
                    for (int n = 0; n < 2; ++n)
#pragma unroll
                        for (int j = 0; j < 4; ++j) { const float ea = 1.0f + __expf(-acc[ai][0][m][n][j]), eb = 1.0f + __expf(-acc[ai][1][m][n][j]);
                            sb[4 * n + j] = __builtin_amdgcn_rcpf(eb); rr[4 * n + j] = eb * __builtin_amdgcn_rcpf(ea); }
                    u32x4 w; w.x = pk2(rr[0], rr[1]); w.y = pk2(rr[2], rr[3]); w.z = pk2(rr[4], rr[5]); w.w = pk2(rr[6], rr[7]); *(u32x4*)(RB + off) = w;
                    w.x = pk2(sb[0], sb[1]); w.y = pk2(sb[2], sb[3]); w.z = pk2(sb[4], sb[5]); w.w = pk2(sb[6], sb[7]); *(u32x4*)(SB + off) = w;
                }
            return;
        }
#pragma unroll
        for (int ai = 0; ai < 2; ++ai)
#pragma unroll
            for (int m = 0; m < 4; ++m) {
                bf16_t* rowp = Z + (size_t)(row0 + ai * 128 + m * 16) * ZP + col0;
#pragma unroll
                for (int bj = 0; bj < 2; ++bj) { const f32x4 v0 = acc[ai][bj][m][0], v1 = acc[ai][bj][m][1];
                    u32x4 w; w.x = pk2(v0[0], v0[1]); w.y = pk2(v0[2], v0[3]); w.z = pk2(v1[0], v1[1]); w.w = pk2(v1[2], v1[3]);
                    *(u32x4*)(rowp + bj * 128) = w; }
            }
        if (u.pn <= 2) {
#pragma unroll
            for (int ai = 0; ai < 2; ++ai)
#pragma unroll
                for (int m = 0; m < 4; ++m) {
                    float s[2];
#pragma unroll
                    for (int bj = 0; bj < 2; ++bj) { const f32x4 v0 = acc[ai][bj][m][0], v1 = acc[ai][bj][m][1];
                        s[bj] = (v0[0] * v0[0] + v0[1] * v0[1]) + (v0[2] * v0[2] + v0[3] * v0[3]) + (v1[0] * v1[0] + v1[1] * v1[1]) + (v1[2] * v1[2] + v1[3] * v1[3]); }
                    float sq = 0.f, sk = 0.f;
                    if (u.pn == 0) sq = s[0] + s[1]; else if (u.pn == 1) { sq = s[0]; sk = s[1]; } else sk = s[0];
                    sq = sum_fq(sq); sk = sum_fq(sk);
                    const int row = row0 + ai * 128 + m * 16;
                    if (fq == 0) { if (u.pn <= 1) add_agent(ssq + row, sq); if (u.pn >= 1) add_agent(sskv + row, sk); }
                }
        }
    }
};
struct EpiRowScale {
    static constexpr bool PERM = true, AFTER_DRAIN = false, HAS_MID = false;
    bf16_t* O; int ldo; const float* ss; float invn; float scale;
    DI void operator()(const f32x4 (&acc)[2][2][4][2], const Unit& u, int wr, int wc, int fr, int fq) const {
        const int row0 = u.pm * 256 + wr * 64 + fr, col0 = u.pn * 256 + wc * 32 + 8 * fq;
        float ssv[2][4];
#pragma unroll
        for (int ai = 0; ai < 2; ++ai)
#pragma unroll
            for (int m = 0; m < 4; ++m) ssv[ai][m] = ld_agent(ss + row0 + ai * 128 + m * 16);
#pragma unroll
        for (int ai = 0; ai < 2; ++ai)
#pragma unroll
            for (int m = 0; m < 4; ++m) {
                const int row = row0 + ai * 128 + m * 16;
                const float rs = __builtin_amdgcn_rsqf(ssv[ai][m] * invn + EPS) * scale;
                bf16_t* rowp = O + (size_t)row * ldo + col0;
#pragma unroll
                for (int bj = 0; bj < 2; ++bj) { const f32x4 v0 = acc[ai][bj][m][0] * rs, v1 = acc[ai][bj][m][1] * rs;
                    u32x4 w; w.x = pk2(v0[0], v0[1]); w.y = pk2(v0[2], v0[3]); w.z = pk2(v1[0], v1[1]); w.w = pk2(v1[2], v1[3]);
                    *(u32x4*)(rowp + bj * 128) = w; }
            }
    }
};
struct EpiMix2 {
    static constexpr bool PERM = true, AFTER_DRAIN = false, HAS_MID = true;
    bf16_t* MIX; const bf16_t* RB; const bf16_t* SB;
    DI void mid(f32x4 (&acc)[2][2][4][2], const Unit& u, int wr, int wc, int fr, int fq) const {
        const int row0 = u.pm * 256 + wr * 64 + fr, col0 = u.pn * 256 + wc * 32 + 8 * fq;
#pragma unroll
        for (int ai = 0; ai < 2; ++ai)
#pragma unroll
            for (int m = 0; m < 4; ++m) {
                const bf16_t* gp = RB + (size_t)(row0 + ai * 128 + m * 16) * 1024 + col0;
#pragma unroll
                for (int bj = 0; bj < 2; ++bj) {
                    const u32x4 r = __builtin_nontemporal_load((const u32x4*)(gp + bj * 128));
#pragma unroll
                    for (int k = 0; k < 4; ++k) { acc[ai][bj][m][k >> 1][(k & 1) * 2] *= bflo(r[k]); acc[ai][bj][m][k >> 1][(k & 1) * 2 + 1] *= bfhi(r[k]); }
                }
                if (m & 1) asm volatile("" ::: "memory");
            }
    }
    DI void operator()(const f32x4 (&acc)[2][2][4][2], const Unit& u, int wr, int wc, int fr, int fq) const {
        const int row0 = u.pm * 256 + wr * 64 + fr, col0 = u.pn * 256 + wc * 32 + 8 * fq;
#pragma unroll
        for (int ai = 0; ai < 2; ++ai)
#pragma unroll
            for (int m = 0; m < 4; ++m) {
                const int row = row0 + ai * 128 + m * 16;
                bf16_t* rowp = MIX + (size_t)row * 1024 + col0; const bf16_t* gp = SB + (size_t)row * 1024 + col0;
#pragma unroll
                for (int bj = 0; bj < 2; ++bj) {
                    const u32x4 g = __builtin_nontemporal_load((const u32x4*)(gp + bj * 128));
                    const f32x4 a0 = acc[ai][bj][m][0], a1 = acc[ai][bj][m][1];
                    u32x4 w;
                    w.x = pk2(a0[0] * bflo(g.x), a0[1] * bfhi(g.x)); w.y = pk2(a0[2] * bflo(g.y), a0[3] * bfhi(g.y));
                    w.z = pk2(a1[0] * bflo(g.z), a1[1] * bfhi(g.z)); w.w = pk2(a1[2] * bflo(g.w), a1[3] * bfhi(g.w));
                    *(u32x4*)(rowp + bj * 128) = w;
                }
            }
    }
};
template <bool WB> struct EpiRes {
    static constexpr bool PERM = true, AFTER_DRAIN = false, HAS_MID = false;
    const float* base; float* out; bf16_t* ob; float* ss;
    DI void operator()(const f32x4 (&acc)[2][2][4][2], const Unit& u, int wr, int wc, int fr, int fq) const {
        const int row0 = u.pm * 256 + wr * 64 + fr, col0 = u.pn * 256 + wc * 32 + 8 * fq;
#pragma unroll
        for (int ai = 0; ai < 2; ++ai)
#pragma unroll
            for (int m = 0; m < 4; ++m) {
                const int row = row0 + ai * 128 + m * 16; const size_t off = (size_t)row * 1024 + col0; float s = 0.f;
#pragma unroll
                for (int bj = 0; bj < 2; ++bj) {
                    const f32x4 b0 = __builtin_nontemporal_load((const f32x4*)(base + off + bj * 128)), b1 = __builtin_nontemporal_load((const f32x4*)(base + off + bj * 128 + 4));
                    const f32x4 v0 = b0 + acc[ai][bj][m][0], v1 = b1 + acc[ai][bj][m][1];
                    if (!WB) { *(f32x4*)(out + off + bj * 128) = v0; *(f32x4*)(out + off + bj * 128 + 4) = v1; }
                    s += (v0[0] * v0[0] + v0[1] * v0[1]) + (v0[2] * v0[2] + v0[3] * v0[3]) + (v1[0] * v1[0] + v1[1] * v1[1]) + (v1[2] * v1[2] + v1[3] * v1[3]);
                    if (WB) { u32x4 w; w.x = pk2(v0[0], v0[1]); w.y = pk2(v0[2], v0[3]); w.z = pk2(v1[0], v1[1]); w.w = pk2(v1[2], v1[3]); *(u32x4*)(ob + off + bj * 128) = w; }
                }
                s = sum_fq(s);
                if (fq == 0) add_agent(ss + row, s);
            }
    }
};
struct EpiResNorm {
    static constexpr bool PERM = true, AFTER_DRAIN = true, HAS_MID = false;
    const bf16_t* base; float* out; float* ss; const float* gain; unsigned* pcnt; unsigned* bar;
    DI void fused(f32x4 (&acc)[2][2][4][2], const Unit& u, int wr, int wc, int fr, int fq, LAS unsigned char* lds, int wid, int lane) const {
        const int row0 = u.pm * 256 + wr * 64 + fr, col0 = u.pn * 256 + wc * 32 + 8 * fq;
#pragma unroll
        for (int ai = 0; ai < 2; ++ai)
#pragma unroll
            for (int m = 0; m < 4; ++m) {
                const int row = row0 + ai * 128 + m * 16; const size_t off = (size_t)row * 1024 + col0; float s = 0.f;
#pragma unroll
                for (int bj = 0; bj < 2; ++bj) {
                    const u32x4 hb = *(const u32x4*)(base + off + bj * 128);
                    const f32x4 b0 = {bflo(hb.x), bfhi(hb.x), bflo(hb.y), bfhi(hb.y)}, b1 = {bflo(hb.z), bfhi(hb.z), bflo(hb.w), bfhi(hb.w)};
                    const f32x4 v0 = b0 + acc[ai][bj][m][0], v1 = b1 + acc[ai][bj][m][1];
                    acc[ai][bj][m][0] = v0; acc[ai][bj][m][1] = v1;
                    s += (v0[0] * v0[0] + v0[1] * v0[1]) + (v0[2] * v0[2] + v0[3] * v0[3]) + (v1[0] * v1[0] + v1[1] * v1[1]) + (v1[2] * v1[2] + v1[3] * v1[3]);
                }
                s = sum_fq(s);
                if (fq == 0) add_agent(ss + row, s);
                if (m & 1) asm volatile("" ::: "memory");
            }
        asm volatile("s_waitcnt vmcnt(0)" ::: "memory");
        __syncthreads();
        if (threadIdx.x == 0) { (void)xb_add(pcnt + 64 * u.pm, 1u); XB_SPIN(xb_ld(pcnt + 64 * u.pm) < 4u, bar); }
        __syncthreads();
        f32x4 gn[2][2];
#pragma unroll
        for (int bj = 0; bj < 2; ++bj) { gn[bj][0] = *(const f32x4*)(gain + col0 + bj * 128); gn[bj][1] = *(const f32x4*)(gain + col0 + bj * 128 + 4); }
        float ssv[2][4];
#pragma unroll
        for (int ai = 0; ai < 2; ++ai)
#pragma unroll
            for (int m = 0; m < 4; ++m) ssv[ai][m] = ld_agent(ss + row0 + ai * 128 + m * 16);
#pragma unroll
        for (int ai = 0; ai < 2; ++ai)
#pragma unroll
            for (int m = 0; m < 4; ++m) {
                const int row = row0 + ai * 128 + m * 16; const size_t off = (size_t)row * 1024 + col0;
                const float rs = __builtin_amdgcn_rsqf(ssv[ai][m] * (1.0f / 1024.0f) + EPS);
#pragma unroll
                for (int bj = 0; bj < 2; ++bj) { __builtin_nontemporal_store(acc[ai][bj][m][0] * rs * gn[bj][0], (f32x4*)(out + off + bj * 128)); __builtin_nontemporal_store(acc[ai][bj][m][1] * rs * gn[bj][1], (f32x4*)(out + off + bj * 128 + 4)); }
            }
    }
};
struct EpiFfn {
    static constexpr bool PERM = true, AFTER_DRAIN = false, HAS_MID = false;
    bf16_t* ACT; const float* ss;
    DI void operator()(const f32x4 (&acc)[2][2][4][2], const Unit& u, int wr, int wc, int fr, int fq) const {
        const int row0 = u.pm * 256 + wr * 64 + fr, col0 = u.pn * 128 + wc * 32 + 8 * fq;
        float ssv[2][4];
#pragma unroll
        for (int ai = 0; ai < 2; ++ai)
#pragma unroll
            for (int m = 0; m < 4; ++m) ssv[ai][m] = ld_agent(ss + row0 + ai * 128 + m * 16);
#pragma unroll
        for (int ai = 0; ai < 2; ++ai)
#pragma unroll
            for (int m = 0; m < 4; ++m) {
                const int row = row0 + ai * 128 + m * 16;
                const float rs = __builtin_amdgcn_rsqf(ssv[ai][m] * (1.0f / 1024.0f) + EPS);
                float v[8];
#pragma unroll
                for (int n = 0; n < 2; ++n)
#pragma unroll
                    for (int j = 0; j < 4; ++j) { const float g = acc[ai][0][m][n][j] * rs, up = acc[ai][1][m][n][j] * rs; v[n * 4 + j] = g * sigmoidf_(g) * up; }
                u32x4 w; w.x = pk2(v[0], v[1]); w.y = pk2(v[2], v[3]); w.z = pk2(v[4], v[5]); w.w = pk2(v[6], v[7]);
                *(u32x4*)(ACT + (size_t)row * DFF + col0) = w;
            }
    }
};

DI float wave_sum(float v) {
    v += __builtin_bit_cast(float, __builtin_amdgcn_update_dpp(0, __builtin_bit_cast(int, v), 0xB1, 0xF, 0xF, false));
    v += __builtin_bit_cast(float, __builtin_amdgcn_update_dpp(0, __builtin_bit_cast(int, v), 0x4E, 0xF, 0xF, false));
    v += __builtin_bit_cast(float, __builtin_amdgcn_update_dpp(0, __builtin_bit_cast(int, v), 0x141, 0xF, 0xF, false));
    v += __builtin_bit_cast(float, __builtin_amdgcn_update_dpp(0, __builtin_bit_cast(int, v), 0x140, 0xF, 0xF, false));
    return sum_fq(v);
}
DI void transpose_item(const float* __restrict__ W, int K, int N, const float* __restrict__ ksc, bf16_t* __restrict__ WT, int dst_row0, int k0, int n0, float* scr, int lane, int ldw = 0, int kofs = 0, int dst_row16 = -1) {
    if (ldw == 0) ldw = K;
    if (dst_row16 < 0) dst_row16 = dst_row0 + 16;
    const int nq = n0 + 4 * (lane & 7), kr = lane >> 3;
    f32x4 v[8];
#pragma unroll
    for (int i = 0; i < 8; ++i) v[i] = (nq < N) ? __builtin_nontemporal_load((const f32x4*)(W + (size_t)(k0 + 8 * i + kr) * N + nq)) : (f32x4){0.f, 0.f, 0.f, 0.f};
#pragma unroll
    for (int i = 0; i < 8; ++i) { const int kk = 8 * i + kr; const float sc = ksc ? ksc[k0 + kk] : 1.0f; float* d = scr + kk * 33 + 4 * (lane & 7);
        d[0] = v[i].x * sc; d[1] = v[i].y * sc; d[2] = v[i].z * sc; d[3] = v[i].w * sc; }
    asm volatile("s_waitcnt lgkmcnt(0)" ::: "memory");
    const int c = lane & 7;
#pragma unroll
    for (int j = 0; j < 4; ++j) { const int nn = (lane >> 3) + 8 * j; const float* s = scr + (8 * c) * 33 + nn;
        u32x4 o; o.x = pk2(s[0 * 33], s[1 * 33]); o.y = pk2(s[2 * 33], s[3 * 33]); o.z = pk2(s[4 * 33], s[5 * 33]); o.w = pk2(s[6 * 33], s[7 * 33]);
        *(u32x4*)(WT + (size_t)(nn < 16 ? dst_row0 + nn : dst_row16 + nn - 16) * ldw + kofs + k0 + 8 * c) = o; }
    asm volatile("s_waitcnt lgkmcnt(0)" ::: "memory");
}
DI int win_row(int c) { return c < 2224 ? c : c < 3248 ? 2304 + 256 * ((c - 2224) >> 7) + ((c - 2224) & 127) : c < 4272 ? 2304 + 256 * ((c - 3248) >> 7) + 128 + ((c - 3248) & 127) : 2224 + (c - 4272); }
constexpr int I_IN = 16 * 136, I_UQ = 6 * 24, I_UKV = 4 * 32, I_OA = 8 * 32, I_OUT = 16 * 32, I_F = 16 * 88, I_D = 44 * 32;
constexpr int NITEMS_EARLY = I_IN + I_UQ + I_UKV;
constexpr int NITEMS = NITEMS_EARLY + 2 * I_OA + I_OUT + 2 * I_F + I_D;
DI void weight_items(const Params& P, unsigned char* lds, int it_lo, int it_hi, int gw, int NGW) {
    const int lane = threadIdx.x & 63, wave = threadIdx.x >> 6;
    float* scr = (float*)(lds + wave * 16384);
    unsigned char* ws = P.ws;
    for (int it = it_lo + gw; it < it_hi; it += NGW) {
        int r = it;
        if (r < I_IN) { const int kb = r / 136, nb = r % 136; if (nb * 32 >= DIN) continue;
            transpose_item(P.w_in, 1024, DIN, nullptr, (bf16_t*)(ws + WS_WIN), win_row(nb * 32), kb * 64, nb * 32, scr, lane, 0, 0, win_row(nb * 32 + 16)); continue; } r -= I_IN;
        if (r < I_UQ) { const int kb = r / 24, nb = r % 24; transpose_item(P.w_uq, 384, 768, P.norm_cq, (bf16_t*)(ws + WS_WUQ), nb * 32, kb * 64, nb * 32, scr, lane); continue; } r -= I_UQ;
        if (r < I_UKV) { const int kb = r / 32, nb = r % 32; transpose_item(P.w_ukv, 256, 1024, P.norm_ckv, (bf16_t*)(ws + WS_WUKV), nb * 32, kb * 64, nb * 32, scr, lane); continue; } r -= I_UKV;
        if (r < I_OA) { const int kb = r / 32, nb = r % 32; transpose_item(P.w_oa, 512, 1024, nullptr, (bf16_t*)(ws + WS_WOA), nb * 32, kb * 64, nb * 32, scr, lane, 1024, 0); continue; } r -= I_OA;
        if (r < I_OA) { const int kb = r / 32, nb = r % 32; transpose_item(P.w_ob, 512, 1024, nullptr, (bf16_t*)(ws + WS_WOA), nb * 32, kb * 64, nb * 32, scr, lane, 1024, 512); continue; } r -= I_OA;
        if (r < I_OUT) { const int kb = r / 32, nb = r % 32; transpose_item(P.w_out, 1024, 1024, nullptr, (bf16_t*)(ws + WS_WOUT), nb * 32, kb * 64, nb * 32, scr, lane); continue; } r -= I_OUT;
        if (r < I_F) { const int kb = r / 88, nb = r % 88, n0 = nb * 32; transpose_item(P.w_fg, 1024, DFF, P.ln_ffn, (bf16_t*)(ws + WS_WGU), 256 * (n0 >> 7) + (n0 & 127), kb * 64, n0, scr, lane); continue; } r -= I_F;
        if (r < I_F) { const int kb = r / 88, nb = r % 88, n0 = nb * 32; transpose_item(P.w_fu, 1024, DFF, P.ln_ffn, (bf16_t*)(ws + WS_WGU), 256 * (n0 >> 7) + 128 + (n0 & 127), kb * 64, n0, scr, lane); continue; } r -= I_F;
        { const int kb = r / 32, nb = r % 32; transpose_item(P.w_fd, DFF, 1024, nullptr, (bf16_t*)(ws + WS_WD), nb * 32, kb * 64, nb * 32, scr, lane); }
    }
}
DI void phase0(const Params& P, unsigned char* lds) {
    const int tid = threadIdx.x, lane = tid & 63, wave = tid >> 6;
    const int gw = blockIdx.x * 8 + wave, NGW = gridDim.x * 8;
    unsigned char* ws = P.ws;
    weight_items(P, lds, 0, NITEMS_EARLY, gw, NGW);
    bf16_t* U = (bf16_t*)(ws + WS_U);
    for (int m = 8 * gw; m < NTOK; m += 8 * NGW) {
        const f32x4* xr = (const f32x4*)(P.x + (size_t)m * DM) + lane; const f32x4* wr_ = (const f32x4*)P.ln_mix + lane;
        f32x4 v[8][4]; float ss8[8] = {0.f, 0.f, 0.f, 0.f, 0.f, 0.f, 0.f, 0.f};
#pragma unroll
        for (int q = 0; q < 8; ++q)
#pragma unroll
            for (int j = 0; j < 4; ++j) v[q][j] = __builtin_nontemporal_load(xr + 256 * q + 64 * j);
#pragma unroll
        for (int q = 0; q < 8; ++q)
#pragma unroll
            for (int j = 0; j < 4; ++j) ss8[q] += (v[q][j].x * v[q][j].x + v[q][j].y * v[q][j].y) + (v[q][j].z * v[q][j].z + v[q][j].w * v[q][j].w);
        float rq[8];
#pragma unroll
        for (int q = 0; q < 8; ++q) rq[q] = __builtin_amdgcn_rsqf(wave_sum(ss8[q]) * (1.0f / DM) + EPS);
        u32x2* o8 = (u32x2*)(U + (size_t)m * DM) + lane;
#pragma unroll
        for (int j = 0; j < 4; ++j) { const f32x4 g = wr_[64 * j];
#pragma unroll
            for (int q = 0; q < 8; ++q) { u32x2 w; w.x = pk2(v[q][j].x * rq[q] * g.x, v[q][j].y * rq[q] * g.y); w.y = pk2(v[q][j].z * rq[q] * g.z, v[q][j].w * rq[q] * g.w); o8[256 * q + 64 * j] = w; } }
    }
    const int gt = blockIdx.x * NTHREADS + tid, NGT = gridDim.x * NTHREADS;
    float* cs = (float*)(ws + WS_COS); float* sn = (float*)(ws + WS_SIN);
    for (int e = gt; e < NTOK * 16; e += NGT) {
        const int row = e >> 4, i = e & 15;
        const float inv = exp2f(-(float)i * (13.287712379549449f / 16.0f));
        const float ang = (float)P.pos[row] * inv;
        float rev = ang * 0.15915494309189535f; rev = rev - floorf(rev);
        cs[e] = __builtin_amdgcn_cosf(rev); sn[e] = __builtin_amdgcn_sinf(rev);
    }
    float* ss = (float*)(ws + WS_SS);
    for (int e = gt; e < 4 * NTOK; e += NGT) ss[e] = 0.f;
}

struct GlaARaw { bf16_t k[8]; u32x4 v[2]; u32x4 g; float w[16]; float bias; };
#define GLA_A_LOAD(UNIT, R) do { const int h_ = (UNIT) & 3, n_ = ((UNIT) >> 2) & 31, b_ = (UNIT) >> 7, t_ = b_ * SEQ + 64 * n_; \
    _Pragma("unroll") for (int r = 0; r < 16; ++r) R.w[r] = P.w_gate2[r * 256 + 64 * h_ + lane]; \
    R.bias = P.b_gate[64 * h_ + lane]; \
    R.g = *(const u32x4*)(Zg + (size_t)(t_ + 8 * w + ((lane & 15) >> 1)) * ZP + ZC_GLR + 8 * (lane & 1)); \
    _Pragma("unroll") for (int i = 0; i < 8; ++i) R.k[i] = Zg[(size_t)(t_ + 8 * w + i) * ZP + ZC_GK + 64 * h_ + lane]; \
    _Pragma("unroll") for (int c2 = 0; c2 < 2; ++c2) { const int ch = tid + 512 * c2; R.v[c2] = *(const u32x4*)(Zg + (size_t)(t_ + (ch >> 4)) * ZP + ZC_GV + 128 * h_ + 8 * (ch & 15)); } } while (0)
DI void gla_gate(const u32x4 g, const float (&w)[16], float bias, int seg, int d, float* segsum, float (&b)[8], float& blast) {
    float c = 0.f;
#pragma unroll
    for (int i = 0; i < 8; ++i) {
        float x = bias;
#pragma unroll
        for (int hf = 0; hf < 2; ++hf)
#pragma unroll
            for (int k = 0; k < 4; ++k) { const unsigned wv = (unsigned)__builtin_amdgcn_readlane((int)g[k], 2 * i + hf); x += bflo(wv) * w[8 * hf + 2 * k] + bfhi(wv) * w[8 * hf + 2 * k + 1]; }
        const float ls = fminf(x, 0.f) - __logf(1.0f + __expf(-fabsf(x)));
        c += ls * (1.0f / 16.0f); b[i] = c;
    }
    segsum[seg * 64 + d] = c;
    __syncthreads();
    float pre = 0.f, tot = 0.f;
#pragma unroll
    for (int s = 0; s < 8; ++s) { const float v = segsum[s * 64 + d]; tot += v; if (s < seg) pre += v; }
#pragma unroll
    for (int i = 0; i < 8; ++i) b[i] += pre;
    blast = tot;
}
DI void gla_load_v(const bf16_t* Z, int t0, int h, bf16_t* Vs, int tid) {
#pragma unroll
    for (int c2 = 0; c2 < 2; ++c2) { const int ch = tid + 512 * c2, t = ch >> 4, c = ch & 15;
        *(u32x4*)(Vs + t * 160 + 8 * c) = *(const u32x4*)(Z + (size_t)(t0 + t) * ZP + ZC_GV + 128 * h + 8 * c); }
}
DI void gla_a_unit(const Params& P, int unit, int next_unit, bool has_next, unsigned char* lds, GlaARaw& io) {
    const int tid = threadIdx.x, lane = tid & 63, w = __builtin_amdgcn_readfirstlane(tid >> 6);
    const int h = unit & 3, n = (unit >> 2) & 31, bb = unit >> 7, t0 = bb * SEQ + 64 * n, bh = bb * 4 + h;
    const bf16_t* Zg = (const bf16_t*)(P.ws + WS_Z);
    float* segsum = (float*)lds; bf16_t* kdT = (bf16_t*)(lds + 2048); bf16_t* Vs = (bf16_t*)(lds + 11264);
    bf16_t kraw[8]; u32x4 vraw[2]; float wg[16];
#pragma unroll
    for (int i = 0; i < 8; ++i) kraw[i] = io.k[i];
#pragma unroll
    for (int r = 0; r < 16; ++r) wg[r] = io.w[r];
    vraw[0] = io.v[0]; vraw[1] = io.v[1];
    const u32x4 gcur = io.g; const float biasc = io.bias;
    if (has_next) GLA_A_LOAD(next_unit, io);
    float b[8], blast;
    gla_gate(gcur, wg, biasc, w, lane, segsum, b, blast);
    float kd[8];
#pragma unroll
    for (int i = 0; i < 8; ++i) kd[i] = bf2f(kraw[i]) * __expf(blast - b[i]);
    *(bf16x8*)(kdT + lane * 72 + 8 * w) = pack8(kd[0], kd[1], kd[2], kd[3], kd[4], kd[5], kd[6], kd[7]);
    if (w == 0) ((float*)(P.ws + WS_DEC))[(bh * 32 + n) * 64 + lane] = __expf(blast);
    { float* BC = (float*)(P.ws + WS_OM);
#pragma unroll
      for (int i = 0; i < 8; ++i) BC[(size_t)(t0 + 8 * w + i) * 256 + 64 * h + lane] = b[i]; }
#pragma unroll
    for (int c2 = 0; c2 < 2; ++c2) { const int ch = tid + 512 * c2; *(u32x4*)(Vs + (ch >> 4) * 160 + 8 * (ch & 15)) = vraw[c2]; }
    __syncthreads();
    const int r32 = lane & 31, hi = lane >> 5, g1 = (lane >> 4) & 1, q4 = (lane & 15) >> 2, p = lane & 3, dh = w & 1, eb = w >> 1;
    f32x16 acc = {};
#pragma unroll
    for (int ks = 0; ks < 4; ++ks) {
        const bf16x8 a = *(const bf16x8*)(kdT + (32 * dh + r32) * 72 + 16 * ks + 8 * hi);
        const bf16_t* vp = Vs + (16 * ks + 8 * hi + q4) * 160 + 32 * eb + 16 * g1 + 4 * p;
        const bf16x8 bv = cat8(tr_read(vp), tr_read(vp + 4 * 160));
        acc = MFMA32(a, bv, acc);
    }
    bf16_t* ST = (bf16_t*)P.out + ((size_t)(bh * 32 + n) * 128 + 32 * eb + r32) * 64 + 32 * dh + 4 * hi;
#pragma unroll
    for (int rg = 0; rg < 4; ++rg) { u32x2 o; o.x = pk2(acc[4 * rg], acc[4 * rg + 1]); o.y = pk2(acc[4 * rg + 2], acc[4 * rg + 3]); *(u32x2*)(ST + 8 * rg) = o; }
    __syncthreads();
}
DI void gla_scan(const Params& P) {
    const int gt = blockIdx.x * NTHREADS + threadIdx.x, NGT = gridDim.x * NTHREADS;
    const unsigned* ST = (const unsigned*)P.out; unsigned* ST2 = (unsigned*)P.out; const f32x2* DEC = (const f32x2*)(P.ws + WS_DEC);
    for (int item = gt; item < 32 * 128 * 32; item += NGT) {
        const int dp = item & 31, e = (item >> 5) & 127, bh = item >> 12;
        unsigned kv[32]; f32x2 dc[32];
        const size_t idx0 = ((size_t)(bh * 32) * 128 + e) * 32 + dp;
#pragma unroll
        for (int n = 0; n < 32; ++n) { kv[n] = __builtin_nontemporal_load(ST + idx0 + (size_t)n * 128 * 32); dc[n] = DEC[(bh * 32 + n) * 32 + dp]; }
        float s0 = 0.f, s1 = 0.f;
#pragma unroll
        for (int n = 0; n < 32; ++n) { ST2[idx0 + (size_t)n * 128 * 32] = pk2(s0, s1); s0 = dc[n].x * s0 + bflo(kv[n]); s1 = dc[n].y * s1 + bfhi(kv[n]); }
    }
}
struct GlaCRaw { bf16_t q[8], k[8]; u32x4 v[2]; float b[8]; bf16x8 sf[4]; bf16_t og[16]; };
#define GLA_C_LOAD(UNIT, R) do { const int h_ = (UNIT) & 3, n_ = ((UNIT) >> 2) & 31, b_ = (UNIT) >> 7, t_ = b_ * SEQ + 64 * n_, bh_ = b_ * 4 + h_; \
    _Pragma("unroll") for (int i = 0; i < 8; ++i) { const size_t zr = (size_t)(t_ + 8 * w + i) * ZP + 64 * h_ + lane; R.q[i] = Zg[zr + ZC_GQ]; R.k[i] = Zg[zr + ZC_GK]; R.b[i] = BCg[(size_t)(t_ + 8 * w + i) * 256 + 64 * h_ + lane]; } \
    { const bf16_t* ST_ = (const bf16_t*)P.out + ((size_t)(bh_ * 32 + n_) * 128 + 32 * eb + r32) * 64 + 8 * hi; \
      _Pragma("unroll") for (int ds = 0; ds < 4; ++ds) R.sf[ds] = *(const bf16x8*)(ST_ + 16 * ds); \
      _Pragma("unroll") for (int r = 0; r < 16; ++r) R.og[r] = Zg[(size_t)(t_ + 32 * ih + (r & 3) + 8 * (r >> 2) + 4 * hi) * ZP + ZC_OG + 128 * h_ + 32 * eb + r32]; } \
    _Pragma("unroll") for (int c2 = 0; c2 < 2; ++c2) { const int ch = tid + 512 * c2; R.v[c2] = *(const u32x4*)(Zg + (size_t)(t_ + (ch >> 4)) * ZP + ZC_GV + 128 * h_ + 8 * (ch & 15)); } } while (0)
DI void gla_c_unit(const Params& P, int unit, int next_unit, bool has_next, unsigned char* lds, GlaCRaw& io, float gn) {
    const int tid = threadIdx.x, lane = tid & 63, w = __builtin_amdgcn_readfirstlane(tid >> 6);
    const int h = unit & 3, n = (unit >> 2) & 31, bb = unit >> 7, t0 = bb * SEQ + 64 * n;
    const bf16_t* Z = (const bf16_t*)(P.ws + WS_Z); const bf16_t* Zg = Z; const float* BCg = (const float*)(P.ws + WS_OM);
    bf16_t* qe_s = (bf16_t*)(lds + 2048); bf16_t* ke_s = (bf16_t*)(lds + 11264); bf16_t* Vs = (bf16_t*)(lds + 20480); float* red = (float*)(lds + 40960);
    const int r32 = lane & 31, hi = lane >> 5, g1 = (lane >> 4) & 1, q4 = (lane & 15) >> 2, p = lane & 3, ih = w & 1, eb = w >> 1;
    bf16_t qraw[8], kraw[8]; u32x4 vraw[2]; float b[8]; bf16x8 sf[4]; bf16_t ograw[16];
#pragma unroll
    for (int i = 0; i < 8; ++i) { qraw[i] = io.q[i]; kraw[i] = io.k[i]; b[i] = io.b[i]; }
    vraw[0] = io.v[0]; vraw[1] = io.v[1];
#pragma unroll
    for (int ds = 0; ds < 4; ++ds) sf[ds] = io.sf[ds];
#pragma unroll
    for (int r = 0; r < 16; ++r) ograw[r] = io.og[r];
    if (has_next) GLA_C_LOAD(next_unit, io);
#pragma unroll
    for (int i = 0; i < 8; ++i) {
        const float q = bf2f(qraw[i]), k = bf2f(kraw[i]);
        const unsigned pq = pk2(q * 0.125f * __expf(b[i]), k * __expf(-b[i]));
        qe_s[(8 * w + i) * 72 + lane] = (bf16_t)(pq & 0xffffu); ke_s[(8 * w + i) * 72 + lane] = (bf16_t)(pq >> 16);
    }
#pragma unroll
    for (int c2 = 0; c2 < 2; ++c2) { const int ch = tid + 512 * c2; *(u32x4*)(Vs + (ch >> 4) * 160 + 8 * (ch & 15)) = vraw[c2]; }
    __syncthreads();
    bf16x8 qf[4];
#pragma unroll
    for (int ds = 0; ds < 4; ++ds) qf[ds] = *(const bf16x8*)(qe_s + (32 * ih + r32) * 72 + 16 * ds + 8 * hi);
    f32x16 x0 = {}, x1 = {};
#pragma unroll
    for (int ds = 0; ds < 4; ++ds) x0 = MFMA32(*(const bf16x8*)(ke_s + r32 * 72 + 16 * ds + 8 * hi), qf[ds], x0);
    if (ih == 1) {
#pragma unroll
        for (int ds = 0; ds < 4; ++ds) x1 = MFMA32(*(const bf16x8*)(ke_s + (32 + r32) * 72 + 16 * ds + 8 * hi), qf[ds], x1);
    }
#pragma unroll
    for (int r = 0; r < 16; ++r) { const int j = (r & 3) + 8 * (r >> 2) + 4 * hi; if (j > r32) { if (ih == 0) x0[r] = 0.f; else x1[r] = 0.f; } }
    f32x16 o = {};
#pragma unroll
    for (int s = 0; s < 2; ++s) {
        const bf16x8 pf = pack8(x0[8 * s], x0[8 * s + 1], x0[8 * s + 2], x0[8 * s + 3], x0[8 * s + 4], x0[8 * s + 5], x0[8 * s + 6], x0[8 * s + 7]);
        const bf16_t* vp = Vs + (16 * s + 4 * hi + q4) * 160 + 32 * eb + 16 * g1 + 4 * p;
        o = MFMA32(pf, cat8(tr_read(vp), tr_read(vp + 8 * 160)), o);
    }
    if (ih == 1) {
#pragma unroll
        for (int s = 0; s < 2; ++s) {
            const bf16x8 pf = pack8(x1[8 * s], x1[8 * s + 1], x1[8 * s + 2], x1[8 * s + 3], x1[8 * s + 4], x1[8 * s + 5], x1[8 * s + 6], x1[8 * s + 7]);
            const bf16_t* vp = Vs + (32 + 16 * s + 4 * hi + q4) * 160 + 32 * eb + 16 * g1 + 4 * p;
            o = MFMA32(pf, cat8(tr_read(vp), tr_read(vp + 8 * 160)), o);
        }
    }
#pragma unroll
    for (int ds = 0; ds < 4; ++ds) o = MFMA32(qf[ds], sf[ds], o);
    float sq[16];
#pragma unroll
    for (int r = 0; r < 16; ++r) {
        float v = o[r] * o[r];
        v += __builtin_bit_cast(float, __builtin_amdgcn_update_dpp(0, __builtin_bit_cast(int, v), 0xB1, 0xF, 0xF, false));
        v += __builtin_bit_cast(float, __builtin_amdgcn_update_dpp(0, __builtin_bit_cast(int, v), 0x4E, 0xF, 0xF, false));
        v += __builtin_bit_cast(float, __builtin_amdgcn_update_dpp(0, __builtin_bit_cast(int, v), 0x141, 0xF, 0xF, false));
        v += __builtin_bit_cast(float, __builtin_amdgcn_update_dpp(0, __builtin_bit_cast(int, v), 0x140, 0xF, 0xF, false));
        v += __builtin_bit_cast(float, __builtin_amdgcn_update_dpp(0, __builtin_bit_cast(int, v), 0x142, 0xA, 0xF, false));
        sq[r] = v; }
    if (r32 == 16) {
#pragma unroll
        for (int r = 0; r < 16; ++r) red[eb * 64 + 32 * ih + (r & 3) + 8 * (r >> 2) + 4 * hi] = sq[r];
    }
    __syncthreads();
    bf16_t* GO = (bf16_t*)P.out + 16 * MiB / 2;
#pragma unroll
    for (int r = 0; r < 16; ++r) {
        const int i = 32 * ih + (r & 3) + 8 * (r >> 2) + 4 * hi;
        const float tot = red[i] + red[64 + i] + red[128 + i] + red[192 + i];
        const float rs = __builtin_amdgcn_rsqf(tot * (1.0f / 128.0f) + EPS);
        const float og = bf2f(ograw[r]);
        const float v = o[r] * rs * gn * (og * sigmoidf_(og));
        GO[(size_t)(t0 + i) * 1024 + 512 + 128 * h + 32 * eb + r32] = (bf16_t)(pk2(v, 0.f) & 0xffffu);
    }
    __syncthreads();
}

DI void attn_unit(const Params& P, int bb, int h, int qb, unsigned char* lds) {
    const int tid = threadIdx.x, lane = tid & 63, w = __builtin_amdgcn_readfirstlane(tid >> 6);
    const int r32 = lane & 31, hi = lane >> 5, g1 = (lane >> 4) & 1, q4 = (lane & 15) >> 2, p = lane & 3;
    bf16_t* Ks = (bf16_t*)lds; bf16_t* Vs = (bf16_t*)(lds + 26624); float* wsf = (float*)(lds + 63488) + w * 32;
    const bf16_t* Q = (const bf16_t*)(P.ws + WS_U); const bf16_t* KV = (const bf16_t*)(P.ws + WS_KV); const bf16_t* KR = (const bf16_t*)(P.ws + WS_KR);
    bf16_t* OM = (bf16_t*)P.out + 16 * MiB / 2;
    const int q0 = qb * 256, qw0 = q0 + 32 * w, myq = qw0 + r32; const size_t rowb = (size_t)bb * SEQ;
    bf16x8 qf[6];
    { const bf16_t* qp = Q + (rowb + myq) * 768 + h * 96 + 8 * hi;
#pragma unroll
      for (int d0 = 0; d0 < 6; ++d0) qf[d0] = __builtin_nontemporal_load((const bf16x8*)(qp + 16 * d0));
      const float* cp = (const float*)(P.ws + WS_COS) + (rowb + myq) * 16 + 8 * hi; const float* sp = (const float*)(P.ws + WS_SIN) + (rowb + myq) * 16 + 8 * hi;
      const f32x4 c0 = *(const f32x4*)cp, c1 = *(const f32x4*)(cp + 4), s0 = *(const f32x4*)sp, s1 = *(const f32x4*)(sp + 4);
      const u32x4 a = __builtin_bit_cast(u32x4, qf[4]), b = __builtin_bit_cast(u32x4, qf[5]); u32x4 ra, rb;
#pragma unroll
      for (int k = 0; k < 4; ++k) { const float x1l = bflo(a[k]), x1h = bfhi(a[k]), x2l = bflo(b[k]), x2h = bfhi(b[k]);
          const float cl = k < 2 ? c0[2 * k] : c1[2 * k - 4], ch = k < 2 ? c0[2 * k + 1] : c1[2 * k - 3], sl = k < 2 ? s0[2 * k] : s1[2 * k - 4], sh = k < 2 ? s0[2 * k + 1] : s1[2 * k - 3];
          ra[k] = pk2(x1l * cl - x2l * sl, x1h * ch - x2h * sh); rb[k] = pk2(x2l * cl + x1l * sl, x2h * ch + x1h * sh); }
      qf[4] = __builtin_bit_cast(bf16x8, ra); qf[5] = __builtin_bit_cast(bf16x8, rb); }
    const int NT = (q0 + 256) / 64;
    const int kkey = tid >> 3, kc = tid & 7, rkey = (tid >> 2) & 63, rc = tid & 3;
    const bf16_t* ksrc = KV + (rowb + kkey) * 1024 + h * 128 + kc * 8;
    const bf16_t* rsrc = KR + (rowb + rkey) * 32 + rc * 8;
    u32x4 kreg, vreg, rreg = {};
#define ATT_LOAD(t) do { kreg = *(const u32x4*)(ksrc + (size_t)(t) * 64 * 1024); vreg = *(const u32x4*)(ksrc + (size_t)(t) * 64 * 1024 + 64); if (w < 4) rreg = *(const u32x4*)(rsrc + (size_t)(t) * 64 * 32); } while (0)
#define ATT_STORE(buf, vbuf) do { *(u32x4*)(Ks + (buf) * 6656 + kkey * 104 + kc * 8) = kreg; *(u32x4*)(Vs + (vbuf) * 6144 + kkey * 96 + kc * 8) = vreg; if (w < 4) *(u32x4*)(Ks + (buf) * 6656 + rkey * 104 + 64 + rc * 8) = rreg; } while (0)
#define ATT_PV(VB) do { const bf16_t* Vb_ = Vs + (VB) * 6144; __builtin_amdgcn_s_setprio(1); _Pragma("unroll") for (int s = 0; s < 4; ++s) { const bf16_t* vp = Vb_ + (16 * s + 4 * hi + q4) * 96 + 16 * g1 + 4 * p; \
        o0 = MFMA32(cat8(tr_read(vp), tr_read(vp + 8 * 96)), pf[s], o0); o1 = MFMA32(cat8(tr_read(vp + 32), tr_read(vp + 8 * 96 + 32)), pf[s], o1); } __builtin_amdgcn_s_setprio(0); } while (0)
    ATT_LOAD(0); ATT_STORE(0, 0);
    __syncthreads();
    float mrow = -INFINITY, lsum = 0.f; f32x16 o0 = {}, o1 = {};
    bf16x8 pf[4] = {}; bool pending = false; const bool grpB = (w >= 4);
    int vcur = 0, vprev = 2, vnext = 1;
    for (int t = 0; t < NT; ++t) {
        if (t + 1 < NT) ATT_LOAD(t + 1);
        if (grpB && pending) { ATT_PV(vprev); pending = false; }
        if (64 * t <= qw0 + 31) {
            const bf16_t* Kb = Ks + (t & 1) * 6656;
            f32x16 p0 = {}, p1 = {};
            __builtin_amdgcn_s_setprio(1);
#pragma unroll
            for (int d0 = 0; d0 < 6; ++d0) {
                const bf16x8 ka = *(const bf16x8*)(Kb + r32 * 104 + 16 * d0 + 8 * hi), kb = *(const bf16x8*)(Kb + (32 + r32) * 104 + 16 * d0 + 8 * hi);
                p0 = MFMA32(ka, qf[d0], p0); p1 = MFMA32(kb, qf[d0], p1);
            }
            __builtin_amdgcn_s_setprio(0);
            if (64 * t + 63 > qw0) {
#pragma unroll
                for (int r = 0; r < 16; ++r) { const int key = 64 * t + (r & 3) + 8 * (r >> 2) + 4 * hi; if (key > myq) p0[r] = -INFINITY; if (key + 32 > myq) p1[r] = -INFINITY; }
            }
            float mx = fmaxf(p0[0], p1[0]);
#pragma unroll
            for (int r = 1; r < 16; ++r) mx = __builtin_fmaxf(__builtin_fmaxf(mx, p0[r]), p1[r]);
            { const auto rr = __builtin_amdgcn_permlane32_swap(__float_as_uint(mx), __float_as_uint(mx), false, false);
              mx = fmaxf(__uint_as_float(rr[0]), __uint_as_float(rr[1])); }
            if (__any(mx > mrow + 8.0f)) {
                const float mnew = fmaxf(mrow, mx), alpha = __builtin_amdgcn_exp2f(mrow - mnew);
                mrow = mnew; lsum *= alpha;
#pragma unroll
                for (int r = 0; r < 16; ++r) { o0[r] *= alpha; o1[r] *= alpha; }
            }
            float rs = 0.f;
#pragma unroll
            for (int r = 0; r < 16; ++r) { p0[r] = __builtin_amdgcn_exp2f(p0[r] - mrow); p1[r] = __builtin_amdgcn_exp2f(p1[r] - mrow); rs += p0[r] + p1[r]; }
            lsum += rs;
            pf[0] = pack8(p0[0], p0[1], p0[2], p0[3], p0[4], p0[5], p0[6], p0[7]); pf[1] = pack8(p0[8], p0[9], p0[10], p0[11], p0[12], p0[13], p0[14], p0[15]);
            pf[2] = pack8(p1[0], p1[1], p1[2], p1[3], p1[4], p1[5], p1[6], p1[7]); pf[3] = pack8(p1[8], p1[9], p1[10], p1[11], p1[12], p1[13], p1[14], p1[15]);
            if (!grpB) ATT_PV(vcur); else pending = true;
        }
        if (t + 1 < NT) ATT_STORE((t + 1) & 1, vnext);
        __syncthreads();
        vprev = vcur; vcur = vnext; vnext = (vnext == 2) ? 0 : vnext + 1;
    }
    if (grpB && pending) ATT_PV(vprev);
#undef ATT_LOAD
#undef ATT_STORE
#undef ATT_PV
    lsum = sum_half(lsum);
    {
      const float inv = 1.0f / lsum; bf16_t* orow = OM + (rowb + myq) * 1024 + h * 64 + 8 * hi;
#pragma unroll
      for (int pr = 0; pr < 2; ++pr)
#pragma unroll
          for (int blk = 0; blk < 2; ++blk) {
              const f32x16& o = blk ? o1 : o0; const int g = 2 * pr;
              const unsigned a0 = pk2(o[4 * g] * inv, o[4 * g + 1] * inv), a1 = pk2(o[4 * g + 2] * inv, o[4 * g + 3] * inv);
              const unsigned b0 = pk2(o[4 * g + 4] * inv, o[4 * g + 5] * inv), b1 = pk2(o[4 * g + 6] * inv, o[4 * g + 7] * inv);
              const auto s0 = __builtin_amdgcn_permlane32_swap(a0, b0, false, false), s1 = __builtin_amdgcn_permlane32_swap(a1, b1, false, false);
              u32x4 wv; wv.x = s0[0]; wv.y = s1[0]; wv.z = s0[1]; wv.w = s1[1];
              *(u32x4*)(orow + 32 * blk + 16 * pr) = wv; } }
    __syncthreads();
}


__global__ void __launch_bounds__(NTHREADS, 2) hybrid_fwd(Params P) {
    extern __shared__ __attribute__((aligned(16))) unsigned char lds[];
    cg::grid_group grid = cg::this_grid();
    LAS unsigned char* ldsg = (LAS unsigned char*)lds;
    unsigned char* ws = P.ws;
    const int lo = P.ph_lo, hi = P.ph_hi, G = gridDim.x, bx = blockIdx.x;
    volatile LAS unsigned* MISC = (volatile LAS unsigned*)(ldsg + 131072 + 1024);
    if (threadIdx.x < 2) MISC[threadIdx.x] = 0u;
    __syncthreads();
    XcdBarrier xbar = xcd_barrier_post((unsigned*)(ws + WS_BAR), MISC);
    if (hi > NPHASE) grid.sync();
#ifndef PHMASK
#define PHMASK 0x3ff
#endif
#define IN(k) (((PHMASK >> (k)) & 1) && lo <= (k) && (k) < hi)
#ifndef REPMASK
#define REPMASK 0
#endif
#define REP(k) for (int rep_ = 0; rep_ < 1 + ((REPMASK >> (k)) & 1); ++rep_)
#define SEAM(k) do { if (IN(k) && IN((k) + 1)) { xcd_barrier(xbar); if ((REPMASK >> 12) & 1) xcd_barrier(xbar); } } while (0)
    bf16_t* Z = (bf16_t*)(ws + WS_Z); float* SS = (float*)(ws + WS_SS);
    float* SSQ = SS, *SSKV = SS + NTOK, *SS2 = SS + 2 * NTOK, *SS3 = SS + 3 * NTOK;
    if (IN(0)) REP(0) { phase0(P, lds); __syncthreads(); } SEAM(0);
    if (IN(1)) {
        pg8::Gemm g{(const bf16_t*)(ws + WS_U), (const bf16_t*)(ws + WS_WIN), NTOK, NIN, 1024, 1024, 1024}; pg8::StaticOrder S; S.init(NTOK, NIN, G, bx);
        REP(1) { EpiZ E{Z, rep_ ? SS + 4 * NTOK : SSQ, rep_ ? SS + 5 * NTOK : SSKV, (bf16_t*)(ws + WS_RB), (bf16_t*)(ws + WS_SB)};
        pg8::gemm_phase<EpiZ, pg8::StaticOrder, true, true>(ldsg, g, S, E); }
        { const int nfull = (NTOK / 256) * (NIN / 256) % G;
          if (nfull == 0) weight_items(P, lds, NITEMS_EARLY, NITEMS, bx * 8 + (threadIdx.x >> 6), G * 8);
          else if (bx >= nfull) weight_items(P, lds, NITEMS_EARLY, NITEMS, (bx - nfull) * 8 + (threadIdx.x >> 6), (G - nfull) * 8); }
    } SEAM(1);
    if (IN(2)) {
#ifndef NO_P2KV
        REP(11) { pg8::Gemm g{Z + ZC_CKV, (const bf16_t*)(ws + WS_WUKV), NTOK, 1024, 256, ZP, 256}; pg8::StaticOrder S; S.init(NTOK, 1024, G, bx);
          EpiRowScale E{(bf16_t*)(ws + WS_KV), 1024, SSKV, 1.0f / 256.0f, 1.0f};
          pg8::gemm_phase<EpiRowScale, pg8::StaticOrder, true, true>(ldsg, g, S, E); }
#endif
#ifndef NO_P2Q
        REP(13) { pg8::Gemm g{Z + ZC_CQ, (const bf16_t*)(ws + WS_WUQ), NTOK, 768, 384, ZP, 384}; pg8::StaticOrder S; S.init(NTOK, 768, G, (bx + 64) % G);
          EpiRowScale E{(bf16_t*)(ws + WS_U), 768, SSQ, 1.0f / 384.0f, QSCALE};
          pg8::gemm_phase<EpiRowScale, pg8::StaticOrder, true, true>(ldsg, g, S, E); }
#endif
        __syncthreads();
        REP(2) {
#ifndef NO_P2KR
        { const int gt = bx * NTHREADS + threadIdx.x, NGT = G * NTHREADS; bf16_t* KR = (bf16_t*)(ws + WS_KR); const float* cs = (const float*)(ws + WS_COS); const float* sn = (const float*)(ws + WS_SIN);
          for (int e = gt; e < NTOK * 16; e += NGT) { const int row = e >> 4, i = e & 15; const float x1 = bf2f(Z[(size_t)row * ZP + ZC_KR + i]), x2 = bf2f(Z[(size_t)row * ZP + ZC_KR + 16 + i]), c = cs[e], s = sn[e];
              const unsigned pv = pk2(x1 * c - x2 * s, x2 * c + x1 * s); KR[row * 32 + i] = (bf16_t)(pv & 0xffffu); KR[row * 32 + 16 + i] = (bf16_t)(pv >> 16); } }
#endif
#ifndef NO_P2GLA
        { GlaARaw raw; const bf16_t* Zg = Z; const int tid = threadIdx.x, lane = tid & 63, w = __builtin_amdgcn_readfirstlane(tid >> 6);
          if (bx < 1024) GLA_A_LOAD(bx, raw);
          for (int u = bx; u < 1024; u += G) gla_a_unit(P, u, u + G, u + G < 1024, lds, raw); }
#endif
        }
    } SEAM(2);
    if (IN(3)) {
        const int vcu = (G % 8 == 0) ? (bx % 8) * (G / 8) + bx / 8 : bx;
        REP(3) for (int pr = vcu; pr < 256; pr += G) { const int bh = pr >> 2, s = pr & 3; attn_unit(P, bh >> 3, bh & 7, 7 - s, lds); attn_unit(P, bh >> 3, bh & 7, s, lds); }
        gla_scan(P);
    } SEAM(3);
    if (IN(4)) { GlaCRaw raw; const bf16_t* Zg = Z; const float* BCg = (const float*)(ws + WS_OM); const int tid = threadIdx.x, lane = tid & 63, w = __builtin_amdgcn_readfirstlane(tid >> 6);
        const int r32 = lane & 31, hi = lane >> 5, ih = w & 1, eb = w >> 1;
        const float gn = P.gla_norm[32 * eb + r32];
        if (bx < 1024) GLA_C_LOAD(bx, raw);
        for (int u = bx; u < 1024; u += G) gla_c_unit(P, u, u + G, u + G < 1024, lds, raw, gn); } SEAM(4);
    if (IN(5)) {
        pg8::Gemm g{(const bf16_t*)P.out + 16 * MiB / 2, (const bf16_t*)(ws + WS_WOA), NTOK, 1024, 512, 1024, 1024}; pg8::StaticOrder S; S.init(NTOK, 1024, G, bx);
        EpiMix2 E{(bf16_t*)(ws + WS_U), (const bf16_t*)(ws + WS_RB), (const bf16_t*)(ws + WS_SB)}; pg8::gemm_phase<EpiMix2, pg8::StaticOrder, true, true, true>(ldsg, g, S, E);
    } SEAM(5);
    if (IN(6)) {
        pg8::Gemm g{(const bf16_t*)(ws + WS_U), (const bf16_t*)(ws + WS_WOUT), NTOK, 1024, 1024, 1024, 1024}; pg8::StaticOrder S; S.init(NTOK, 1024, G, bx);
        REP(6) { EpiRes<true> E{P.x, P.out, (bf16_t*)(ws + WS_KV), rep_ ? SS + 4 * NTOK : SS2}; pg8::gemm_phase<EpiRes<true>, pg8::StaticOrder, true, true>(ldsg, g, S, E); }
    } SEAM(6);
    if (IN(7)) REP(7) {
        pg8::Gemm g{(const bf16_t*)(ws + WS_KV), (const bf16_t*)(ws + WS_WGU), NTOK, 2 * DFF, 1024, 1024, 1024}; pg8::StaticOrder S; S.init(NTOK, 2 * DFF, G, bx);
        EpiFfn E{(bf16_t*)(ws + WS_Z), SS2}; pg8::gemm_phase<EpiFfn, pg8::StaticOrder, true, true>(ldsg, g, S, E);
    } SEAM(7);
    if (IN(8)) {
        pg8::Gemm g{(const bf16_t*)(ws + WS_Z), (const bf16_t*)(ws + WS_WD), NTOK, 1024, DFF, DFF, DFF}; pg8::StaticOrder S; S.init(NTOK, 1024, G, bx);
        EpiResNorm E{(const bf16_t*)(ws + WS_KV), P.out, SS3, P.final_norm, (unsigned*)(ws + WS_BAR + 16384), xbar.bar};
        pg8::gemm_phase<EpiResNorm, pg8::StaticOrder, false, true>(ldsg, g, S, E);
    }
#undef IN
#undef SEAM
}

#ifndef N_LAUNCHES
#define N_LAUNCHES 1
#endif
extern "C" void kernel_launch(void* const* d_in, const int* in_sizes, int n_in, void* d_out, int out_size, void* d_ws, size_t ws_size, hipStream_t stream) {
    static int grid = 0;
    if (grid == 0) {
        if (n_in != 19 || out_size != NTOK * DM || ws_size < WS_END) { fprintf(stderr, "kernel_launch: unexpected shapes (n_in %d out %d ws %zu)\n", n_in, out_size, ws_size); grid = -1; return; }
        int dev = 0, cus = 0, per_cu = 0;
        (void)hipGetDevice(&dev); (void)hipDeviceGetAttribute(&cus, hipDeviceAttributeMultiprocessorCount, dev);
        if (hipFuncSetAttribute((const void*)hybrid_fwd, hipFuncAttributeMaxDynamicSharedMemorySize, LDS_BYTES) != hipSuccess) { fprintf(stderr, "kernel_launch: hipFuncSetAttribute failed\n"); grid = -1; return; }
        if (hipOccupancyMaxActiveBlocksPerMultiprocessor(&per_cu, (const void*)hybrid_fwd, NTHREADS, LDS_BYTES) != hipSuccess || per_cu < 1) { fprintf(stderr, "kernel_launch: occupancy query says %d\n", per_cu); per_cu = 1; }
        (void)hipGetLastError();
        grid = cus * 1;
        if (grid != 256) { fprintf(stderr, "kernel_launch: built for a 256-CU device (one 256x256 unit per workgroup in the last phase); got %d CUs\n", grid); grid = -1; return; }
    }
    if (grid < 0) return;
    Params p{};
    p.x = (const float*)d_in[0]; p.pos = (const int*)d_in[1]; p.ln_mix = (const float*)d_in[2]; p.w_in = (const float*)d_in[3]; p.norm_cq = (const float*)d_in[4]; p.w_uq = (const float*)d_in[5];
    p.norm_ckv = (const float*)d_in[6]; p.w_ukv = (const float*)d_in[7]; p.w_oa = (const float*)d_in[8]; p.w_gate2 = (const float*)d_in[9]; p.b_gate = (const float*)d_in[10]; p.gla_norm = (const float*)d_in[11];
    p.w_ob = (const float*)d_in[12]; p.w_out = (const float*)d_in[13]; p.ln_ffn = (const float*)d_in[14]; p.w_fg = (const float*)d_in[15]; p.w_fu = (const float*)d_in[16]; p.w_fd = (const float*)d_in[17]; p.final_norm = (const float*)d_in[18];
    p.out = (float*)d_out; p.ws = (unsigned char*)d_ws;
    (void)hipMemsetAsync((char*)d_ws + WS_BAR, 0, 32768, stream);
#if N_LAUNCHES == 1
    p.ph_lo = 0; p.ph_hi = NPHASE;
    void* args[] = {&p};
    hipError_t e = hipLaunchCooperativeKernel((const void*)hybrid_fwd, dim3(grid), dim3(NTHREADS), args, LDS_BYTES, stream);
    if (e != hipSuccess) fprintf(stderr, "cooperative launch failed: %s (grid %d)\n", hipGetErrorString(e), grid);
#else
    for (int ph = 0; ph < NPHASE; ++ph) { p.ph_lo = ph; p.ph_hi = ph + 1; hipLaunchKernelGGL(hybrid_fwd, dim3(grid), dim3(NTHREADS), LDS_BYTES, stream, p); }
#endif
}
```

```cpp
#include <hip/hip_runtime.h>
#include <hip/hip_cooperative_groups.h>
#include <cstdio>
#include <cstdint>
namespace cg = cooperative_groups;
namespace pg8 {
#define PG8_LAS __attribute__((address_space(3)))
typedef unsigned short bf16_t;
typedef short bf16x8 __attribute__((ext_vector_type(8)));
typedef float f32x4 __attribute__((ext_vector_type(4)));
typedef unsigned u32x4 __attribute__((ext_vector_type(4)));
constexpr int BM = 256, BK = 64, HALF = 128, HTB = HALF * BK * 2  , STAGE_BYTES = 8 * HTB, NXCD = 8, WGM = 4;

__host__ __device__ __forceinline__ int lds_byte(int r, int c) { const int st = (r >> 4) * 2 + (c >> 5), rr = r & 15, cc = c & 31, ob = rr * 64 + cc * 2; return st * 1024 + (ob ^ (((ob >> 9) & 1) << 5)); }
__host__ __device__ __forceinline__ void stage_rc(int b, int& R, int& C) { const int st = b / 1024, sb = b % 1024, swz = sb ^ (((sb >> 9) & 1) << 5); R = (st >> 1) * 16 + swz / 64; C = (st & 1) * 32 + (swz % 64) / 2; }
__host__ __device__ __forceinline__ int perm32(int rho) { const int n = rho >> 4, i = rho & 15; return 8 * (i >> 2) + 4 * n + (i & 3); }

struct Unit { int pm, pn, kh; };
struct Gemm { const bf16_t* A; const bf16_t* Bt; int M, N, K, lda, ldb; };

struct StaticOrder {
    int nM, nN, nwg, G, c;
    __host__ __device__ void init(int M, int N, int G_, int c_) { nM = M / BM; nN = N / BM; nwg = nM * nN; G = G_; c = c_; }
    __host__ __device__ bool next(int i, Unit& u) const {
        const long L = (long)i * G + c; if (L >= nwg) return false;
        int wgid = (int)L; { const int q = nwg / NXCD, r = nwg % NXCD, xcd = wgid % NXCD, off = wgid / NXCD; wgid = (xcd < r ? xcd * (q + 1) : r * (q + 1) + (xcd - r) * q) + off; }
        const int nig = WGM * nN, gid = wgid / nig, fm = gid * WGM, gsz = (nM - fm) < WGM ? (nM - fm) : WGM;
        u.pm = fm + ((wgid % nig) % gsz); u.pn = (wgid % nig) / gsz; return true;
    }
    __device__ __forceinline__ void a_ready(const Unit&) const {}
    __device__ __forceinline__ void done(const Unit&) const {}
};

__device__ __forceinline__ unsigned cvt_pk_bf16(float lo, float hi) { unsigned r; asm volatile("v_cvt_pk_bf16_f32 %0, %1, %2" : "=v"(r) : "v"(lo), "v"(hi)); return r; }
template <class Epi, class Sched, bool ALIGN_EPI = false, bool SP2 = false, bool KSPLIT = false>
__device__ __forceinline__ void gemm_phase(PG8_LAS unsigned char* lds, const Gemm g, const Sched& S, const Epi& E) {
    const int tid = threadIdx.x, wid = __builtin_amdgcn_readfirstlane(tid >> 6), lane = tid & 63, wr = wid >> 2, wc = wid & 3, fr = lane & 15, fq = lane >> 4;
    const int K = g.K, nt = K / BK;
    unsigned voffA[2], voffB[2];
#pragma unroll
    for (int i = 0; i < 2; ++i) { int R, C; stage_rc(tid * 16 + i * 8192, R, C); const int Rb = Epi::PERM ? ((R & ~31) + perm32(R & 31)) : R;
        voffA[i] = (unsigned)(R * g.lda + C) * 2u; voffB[i] = (unsigned)(Rb * g.ldb + C) * 2u; }
    const size_t kstep = (size_t)(BK * 2);
    const size_t hstepA = (size_t)HALF * g.lda * 2, hstepB = (size_t)HALF * g.ldb * 2;
    const size_t tstepA = 2 * hstepA, tstepB = 2 * hstepB;
    const unsigned ldsw = (unsigned)wid * 1024u;
    const int aoff = lds_byte(wr * 64 + fr, fq * 8), boff = lds_byte(wc * 32 + fr, fq * 8);
#define PG8_SA(b, h) (((b) * 2 + (h)) * HTB)
#define PG8_SB(b, h) ((4 + (b) * 2 + (h)) * HTB)
#define PG8_STAGE(bufoff, gbase, voff) do { _Pragma("unroll") for (int _i = 0; _i < 2; ++_i) \
        __builtin_amdgcn_global_load_lds((const unsigned*)((const char*)(gbase) + (voff)[_i]), (PG8_LAS unsigned*)(lds + (bufoff) + ldsw + _i * 8192), 16, 0, 0); } while (0)
#define PG8_LDA(dst, b, h) do { _Pragma("unroll") for (int m = 0; m < 4; ++m) _Pragma("unroll") for (int k = 0; k < 2; ++k) dst[m][k] = *(const PG8_LAS bf16x8*)(lds + PG8_SA(b, h) + aoff + m * 2048 + k * 1024); } while (0)
#define PG8_LDB(dst, b, h) do { _Pragma("unroll") for (int n = 0; n < 2; ++n) _Pragma("unroll") for (int k = 0; k < 2; ++k) dst[n][k] = *(const PG8_LAS bf16x8*)(lds + PG8_SB(b, h) + boff + n * 2048 + k * 1024); } while (0)
#define PG8_MMA(ai, bj, At, Bt) do { __builtin_amdgcn_s_setprio(1); _Pragma("unroll") for (int m = 0; m < 4; ++m) _Pragma("unroll") for (int n = 0; n < 2; ++n) _Pragma("unroll") for (int k = 0; k < 2; ++k) \
        acc[ai][bj][m][n] = __builtin_amdgcn_mfma_f32_16x16x32_bf16(Bt[n][k], At[m][k], acc[ai][bj][m][n], 0, 0, 0); __builtin_amdgcn_s_setprio(0); } while (0)
#define PG8_WAIT_V(n) asm volatile("s_waitcnt vmcnt(" #n ")" ::: "memory")
#define PG8_WAIT_L(n) asm volatile("s_waitcnt lgkmcnt(" #n ")" ::: "memory")
#define PG8_BAR __builtin_amdgcn_s_barrier()
#define PG8_SCHED __builtin_amdgcn_sched_barrier(0)
    Unit cur, nxt; int ui = 0;
#define PG8_NEXT(j, u) (KSPLIT ? (u.kh = (j) & 1, S.next((j) >> 1, u)) : (u.kh = 0, S.next((j), u)))
    if (!PG8_NEXT(0, cur)) return;
    f32x4 acc[2][2][4][2];
#pragma unroll
    for (int a = 0; a < 2; ++a)
#pragma unroll
        for (int b = 0; b < 2; ++b)
#pragma unroll
            for (int m = 0; m < 4; ++m)
#pragma unroll
                for (int n = 0; n < 2; ++n) acc[a][b][m][n] = (f32x4){0.f, 0.f, 0.f, 0.f};
    bf16x8 At[4][2], B0[2][2], B1[2][2];
    const char* cA = (const char*)g.A + (size_t)cur.pm * tstepA + (size_t)cur.kh * K * 2; const char* cB = (const char*)g.Bt + (size_t)cur.pn * tstepB + (size_t)cur.kh * K * 2;
    S.a_ready(cur);
    if constexpr (SP2) {
        PG8_STAGE(PG8_SB(0, 0), cB, voffB); PG8_STAGE(PG8_SB(0, 1), cB + hstepB, voffB); PG8_STAGE(PG8_SA(0, 0), cA, voffA); PG8_STAGE(PG8_SA(0, 1), cA + hstepA, voffA);
        if (wr == 1) PG8_BAR;
        PG8_WAIT_V(2); PG8_BAR;
        PG8_STAGE(PG8_SB(1, 0), cB + kstep, voffB); PG8_STAGE(PG8_SA(1, 0), cA + kstep, voffA); PG8_STAGE(PG8_SB(1, 1), cB + hstepB + kstep, voffB);
        PG8_WAIT_V(6); PG8_BAR;
    } else {
        PG8_STAGE(PG8_SB(0, 0), cB, voffB); PG8_STAGE(PG8_SA(0, 0), cA, voffA); PG8_STAGE(PG8_SB(0, 1), cB + hstepB, voffB); PG8_STAGE(PG8_SA(0, 1), cA + hstepA, voffA);
        if (wr == 1) PG8_BAR;
        PG8_WAIT_V(4); PG8_BAR;
        PG8_STAGE(PG8_SB(1, 0), cB + kstep, voffB); PG8_STAGE(PG8_SA(1, 0), cA + kstep, voffA); PG8_STAGE(PG8_SB(1, 1), cB + hstepB + kstep, voffB);
        PG8_WAIT_V(6); PG8_BAR;
    }
    for (;;) {
        const bool has_next = PG8_NEXT(ui + 1, nxt);
        const char* nA = has_next ? (const char*)g.A + (size_t)nxt.pm * tstepA + (size_t)nxt.kh * K * 2 : cA; const char* nB = has_next ? (const char*)g.Bt + (size_t)nxt.pn * tstepB + (size_t)nxt.kh * K * 2 : cB;
        for (int t = 0; t < nt; t += 2) {
            const bool last = (t == nt - 2);
            const char* a1 = cA + (size_t)(t + 1) * kstep;
            const char* a2 = last ? nA : cA + (size_t)(t + 2) * kstep; const char* b2 = last ? nB : cB + (size_t)(t + 2) * kstep;
            const char* a3 = a2 + kstep; const char* b3 = b2 + kstep;
            if (last && has_next) S.a_ready(nxt);
            if constexpr (SP2) {
            PG8_LDB(B0, 0, 0); PG8_LDB(B1, 0, 1); PG8_SCHED; PG8_LDA(At, 0, 0); PG8_STAGE(PG8_SA(1, 1), a1 + hstepA, voffA);
            PG8_WAIT_V(8); PG8_WAIT_L(0); PG8_BAR; PG8_MMA(0, 0, At, B0); PG8_MMA(0, 1, At, B1); PG8_BAR; PG8_SCHED;
            PG8_LDA(At, 0, 1); PG8_STAGE(PG8_SB(0, 0), b2, voffB); PG8_STAGE(PG8_SB(0, 1), b2 + hstepB, voffB); PG8_STAGE(PG8_SA(0, 0), a2, voffA);
            PG8_WAIT_V(8); PG8_WAIT_L(0); PG8_BAR; PG8_MMA(1, 0, At, B0); PG8_MMA(1, 1, At, B1); PG8_BAR; PG8_SCHED;
            PG8_LDB(B0, 1, 0); PG8_LDB(B1, 1, 1); PG8_SCHED; PG8_LDA(At, 1, 0); PG8_STAGE(PG8_SA(0, 1), a2 + hstepA, voffA);
            PG8_WAIT_V(8); PG8_WAIT_L(0); PG8_BAR; PG8_MMA(0, 0, At, B0); PG8_MMA(0, 1, At, B1); PG8_BAR; PG8_SCHED;
            PG8_LDA(At, 1, 1); PG8_STAGE(PG8_SB(1, 0), b3, voffB); PG8_STAGE(PG8_SB(1, 1), b3 + hstepB, voffB); PG8_STAGE(PG8_SA(1, 0), a3, voffA);
            PG8_WAIT_V(8); PG8_WAIT_L(0); PG8_BAR; PG8_MMA(1, 0, At, B0); PG8_MMA(1, 1, At, B1); PG8_BAR; PG8_SCHED;
            } else {
            PG8_LDB(B0, 0, 0); PG8_SCHED; PG8_LDA(At, 0, 0); PG8_STAGE(PG8_SA(1, 1), a1 + hstepA, voffA);
            PG8_WAIT_L(8); PG8_BAR; PG8_WAIT_L(0); PG8_MMA(0, 0, At, B0); PG8_BAR; PG8_SCHED;
            PG8_LDB(B1, 0, 1); PG8_STAGE(PG8_SB(0, 0), b2, voffB);
            PG8_BAR; PG8_WAIT_L(0); PG8_MMA(0, 1, At, B1); PG8_BAR;
            PG8_LDA(At, 0, 1); PG8_STAGE(PG8_SA(0, 0), a2, voffA);
            PG8_BAR; PG8_WAIT_L(0); PG8_MMA(1, 0, At, B0); PG8_BAR; PG8_SCHED;
            PG8_STAGE(PG8_SB(0, 1), b2 + hstepB, voffB);
            PG8_WAIT_V(6); PG8_BAR; PG8_MMA(1, 1, At, B1); PG8_BAR;
            PG8_LDB(B0, 1, 0); PG8_SCHED; PG8_LDA(At, 1, 0); PG8_STAGE(PG8_SA(0, 1), a2 + hstepA, voffA);
            PG8_WAIT_L(8); PG8_BAR; PG8_WAIT_L(0); PG8_MMA(0, 0, At, B0); PG8_BAR; PG8_SCHED;
            PG8_LDB(B1, 1, 1); PG8_STAGE(PG8_SB(1, 0), b3, voffB);
            PG8_BAR; PG8_WAIT_L(0); PG8_MMA(0, 1, At, B1); PG8_BAR;
            PG8_LDA(At, 1, 1); PG8_STAGE(PG8_SA(1, 0), a3, voffA);
            PG8_BAR; PG8_WAIT_L(0); PG8_MMA(1, 0, At, B0); PG8_BAR; PG8_SCHED;
            PG8_STAGE(PG8_SB(1, 1), b3 + hstepB, voffB);
            PG8_WAIT_V(6); PG8_BAR; PG8_MMA(1, 1, At, B1); PG8_BAR;
            }
        }
        if constexpr (ALIGN_EPI) { if (wr == 0) PG8_BAR; }
        if constexpr (KSPLIT) { if (cur.kh == 0) E.mid(acc, cur, wr, wc, fr, fq); else E(acc, cur, wr, wc, fr, fq); }
        else if constexpr (!Epi::AFTER_DRAIN) { E(acc, cur, wr, wc, fr, fq); S.done(cur); }
        if (!has_next) break;
        if (!KSPLIT || cur.kh == 1)
#pragma unroll
        for (int a = 0; a < 2; ++a)
#pragma unroll
            for (int b = 0; b < 2; ++b)
#pragma unroll
                for (int m = 0; m < 4; ++m)
#pragma unroll
                    for (int n = 0; n < 2; ++n) acc[a][b][m][n] = (f32x4){0.f, 0.f, 0.f, 0.f};
        cur = nxt; cA = nA; cB = nB; ++ui;
        if constexpr (ALIGN_EPI) { if (wr == 1) PG8_BAR; }
    }
    PG8_WAIT_V(0);
    if constexpr (!ALIGN_EPI) { if (wr == 0) PG8_BAR; }
    PG8_BAR;
    if constexpr (Epi::AFTER_DRAIN) { E.fused(acc, cur, wr, wc, fr, fq, lds, wid, lane); S.done(cur); }
#undef PG8_NEXT
#undef PG8_SA
#undef PG8_SB
#undef PG8_STAGE
#undef PG8_LDA
#undef PG8_LDB
#undef PG8_MMA
#undef PG8_WAIT_V
#undef PG8_WAIT_L
#undef PG8_BAR
#undef PG8_SCHED
}
}

#define DI __device__ __forceinline__
#define LAS __attribute__((address_space(3)))
typedef unsigned short bf16_t;
typedef short bf16x8 __attribute__((ext_vector_type(8)));
typedef short s16x4 __attribute__((ext_vector_type(4)));
typedef float f32x4 __attribute__((ext_vector_type(4)));
typedef float f32x2 __attribute__((ext_vector_type(2)));
typedef float f32x16 __attribute__((ext_vector_type(16)));
typedef unsigned u32x4 __attribute__((ext_vector_type(4)));
typedef unsigned u32x2 __attribute__((ext_vector_type(2)));

constexpr int NTOK = 16384, SEQ = 2048, NBATCH = 8, DM = 1024, DIN = 4272, NIN = 4352, ZP = 2304, DFF = 2816;
constexpr int ZC_CQ = 0, ZC_CKV = 384, ZC_KR = 640, ZC_GQ = 672, ZC_GK = 928, ZC_GV = 1184, ZC_GLR = 1696, ZC_OG = 1712, ZC_GA = 2224, ZC_GB = 3248;
constexpr float EPS = 1e-6f;
constexpr float QSCALE = 0.10206207261596575f * 1.4426950408889634f;
constexpr int NTHREADS = 512, NPHASE = 9;
constexpr int LDS_BYTES = 139264;
constexpr size_t MiB = 1u << 20;
constexpr size_t WS_SS = 0;
constexpr size_t WS_DEC = 512 * 1024;
constexpr size_t WS_BAR = 768 * 1024;
constexpr size_t WS_COS = 1 * MiB, WS_SIN = 2 * MiB, WS_KR = 3 * MiB;
constexpr size_t WS_WIN = 4 * MiB, WS_WUQ = 13 * MiB, WS_WUKV = 14 * MiB, WS_WOA = 15 * MiB, WS_WOB = 16 * MiB, WS_WOUT = 17 * MiB, WS_WGU = 19 * MiB, WS_WD = 30 * MiB;
constexpr size_t WS_Z = 36 * MiB;
constexpr size_t WS_RB = 108 * MiB, WS_SB = 140 * MiB;
constexpr size_t WS_U = 172 * MiB;
constexpr size_t WS_KV = 204 * MiB;
constexpr size_t WS_OM = 236 * MiB;
constexpr size_t WS_END = 252 * MiB;

DI unsigned pk2(float lo, float hi) { typedef __bf16 bf2 __attribute__((ext_vector_type(2))); f32x2 v = {lo, hi}; bf2 b = __builtin_convertvector(v, bf2); return __builtin_bit_cast(unsigned, b); }
DI float bflo(unsigned u) { return __uint_as_float(u << 16); }
DI float bfhi(unsigned u) { return __uint_as_float(u & 0xffff0000u); }
DI float bf2f(bf16_t v) { return __uint_as_float((unsigned)v << 16); }
DI float sigmoidf_(float x) { return __builtin_amdgcn_rcpf(1.0f + __expf(-x)); }
DI float sum_fq(float v) {
    const auto a = __builtin_amdgcn_permlane16_swap(__float_as_uint(v), __float_as_uint(v), false, false); v = __uint_as_float(a[0]) + __uint_as_float(a[1]);
    const auto b = __builtin_amdgcn_permlane32_swap(__float_as_uint(v), __float_as_uint(v), false, false); return __uint_as_float(b[0]) + __uint_as_float(b[1]);
}
DI float sum_half(float v) { const auto b = __builtin_amdgcn_permlane32_swap(__float_as_uint(v), __float_as_uint(v), false, false); return __uint_as_float(b[0]) + __uint_as_float(b[1]); }
DI float ld_agent(const float* p) { return __hip_atomic_load(p, __ATOMIC_RELAXED, __HIP_MEMORY_SCOPE_AGENT); }
DI void add_agent(float* p, float v) { (void)__hip_atomic_fetch_add(p, v, __ATOMIC_RELAXED, __HIP_MEMORY_SCOPE_AGENT); }
DI s16x4 tr_read(const bf16_t* p) { typedef short v4i16 __attribute__((ext_vector_type(4))); return __builtin_bit_cast(s16x4, __builtin_amdgcn_ds_read_tr16_b64_v4i16((LAS v4i16*)(p))); }
DI bf16x8 cat8(s16x4 a, s16x4 b) { return (bf16x8){a[0], a[1], a[2], a[3], b[0], b[1], b[2], b[3]}; }
#define MFMA32(a, b, c) __builtin_amdgcn_mfma_f32_32x32x16_bf16((a), (b), (c), 0, 0, 0)
DI bf16x8 pack8(float a0, float a1, float a2, float a3, float a4, float a5, float a6, float a7) {
    u32x4 p; p[0] = pk2(a0, a1); p[1] = pk2(a2, a3); p[2] = pk2(a4, a5); p[3] = pk2(a6, a7); return __builtin_bit_cast(bf16x8, p); }

struct Params {
    const float* x; const int* pos; const float* ln_mix; const float* w_in; const float* norm_cq; const float* w_uq; const float* norm_ckv; const float* w_ukv;
    const float* w_oa; const float* w_gate2; const float* b_gate; const float* gla_norm; const float* w_ob; const float* w_out; const float* ln_ffn;
    const float* w_fg; const float* w_fu; const float* w_fd; const float* final_norm;
    float* out; unsigned char* ws; int ph_lo, ph_hi;
};

#define XB_TMO      128
#define XB_XCNT(j)  (256  + 64 * (j))
#define XB_XSUB(j)  (1280 + 64 * (j))
#define XB_XGEN(j)  (2304 + 64 * (j))
#define XB_TOP      3328
#define XB_TOPGEN   3392
#define XCD_BAR_WORDS 3456
#define XB_SPIN_CAP (1u << 20)
DI unsigned xb_ld(unsigned* p)              { return __hip_atomic_load(p, __ATOMIC_RELAXED, __HIP_MEMORY_SCOPE_AGENT); }
DI unsigned xb_add(unsigned* p, unsigned v) { return __hip_atomic_fetch_add(p, v, __ATOMIC_RELAXED, __HIP_MEMORY_SCOPE_AGENT); }
DI unsigned xb_xcc_id() { return (unsigned)__builtin_amdgcn_s_getreg((3 << 11) | 20) & 0xFu; }
#define XB_SPIN(cond, bar) do { unsigned _sp = 0; while (cond) { \
    if ((++_sp & 255u) == 0u) { if (xb_ld(&(bar)[XB_TMO])) break; if (_sp > XB_SPIN_CAP) { atomicAdd(&(bar)[XB_TMO], 1u); break; } } } } while (0)
struct XcdBarrier { unsigned* bar; unsigned x; volatile LAS unsigned* st; };
DI XcdBarrier xcd_barrier_post(unsigned* bar, volatile LAS unsigned* st) {
    XcdBarrier b; b.bar = bar; b.x = xb_xcc_id(); b.st = st;
    if (threadIdx.x == 0) (void)xb_add(&bar[XB_XCNT(b.x)], 1u);
    return b;
}
DI void xcd_barrier_complete(unsigned* bar, unsigned x, unsigned& nloc, unsigned& nx) {
    const unsigned G = gridDim.x * gridDim.y * gridDim.z;
    unsigned sum, cnt, mine, sp = 0u;
    for (;;) {
        sum = 0u; cnt = 0u; mine = 0u;
#pragma unroll
        for (unsigned j = 0; j < 16; ++j) { const unsigned c = xb_ld(&bar[XB_XCNT(j)]); sum += c; cnt += (c > 0u) ? 1u : 0u; mine = (j == x) ? c : mine; }
        if (sum == G) break;
        __builtin_amdgcn_s_sleep(1);
        if ((++sp & 255u) == 0u) { if (xb_ld(&bar[XB_TMO])) break; if (sp > XB_SPIN_CAP) { atomicAdd(&bar[XB_TMO], 1u); break; } }
    }
    nloc = mine > 0u ? mine : 1u; nx = cnt > 0u ? cnt : 1u;
}
DI void xcd_barrier(const XcdBarrier& b) {
    asm volatile("s_waitcnt vmcnt(0)" ::: "memory");
    __syncthreads();
    if (threadIdx.x == 0) {
        unsigned* bar = b.bar;
        __builtin_amdgcn_s_waitcnt(0);
        unsigned nloc = b.st[0], nx = b.st[1];
        if (nloc == 0u) { xcd_barrier_complete(bar, b.x, nloc, nx); b.st[0] = nloc; b.st[1] = nx; }
        const unsigned old = xb_add(&bar[XB_XSUB(b.x)], 1u);
        const unsigned gen = old / nloc;
        if (old + 1u == (gen + 1u) * nloc) {
            __builtin_amdgcn_fence(__ATOMIC_RELEASE, "agent");
            asm volatile("s_waitcnt vmcnt(0)" ::: "memory");
            const unsigned og = xb_add(&bar[XB_TOP], 1u);
            const unsigned tg = og / nx;
            if (og + 1u == (tg + 1u) * nx) xb_add(&bar[XB_TOPGEN], 1u);
            else XB_SPIN(xb_ld(&bar[XB_TOPGEN]) == tg, bar);
            __builtin_amdgcn_fence(__ATOMIC_ACQUIRE, "agent");
            xb_add(&bar[XB_XGEN(b.x)], 1u);
            asm volatile("s_waitcnt vmcnt(0)" ::: "memory");
        } else {
            XB_SPIN(xb_ld(&bar[XB_XGEN(b.x)]) == gen, bar);
            __builtin_amdgcn_fence(__ATOMIC_ACQUIRE, "agent");
            asm volatile("s_waitcnt vmcnt(0)" ::: "memory");
        }
    }
    __syncthreads();
}

using pg8::Unit;
struct EpiZ {
    static constexpr bool PERM = true, AFTER_DRAIN = false, HAS_MID = false;
    bf16_t* Z; float* ssq; float* sskv; bf16_t* RB; bf16_t* SB;
    DI void operator()(const f32x4 (&acc)[2][2][4][2], const Unit& u, int wr, int wc, int fr, int fq) const {
        const int row0 = u.pm * 256 + wr * 64 + fr, col0 = u.pn * 256 + wc * 32 + 8 * fq;
        if (u.pn >= 9) {
            const int gcol = (u.pn - 9) * 128 + wc * 32 + 8 * fq;
#pragma unroll
            for (int ai = 0; ai < 2; ++ai)
#pragma unroll
                for (int m = 0; m < 4; ++m) {
                    const size_t off = (size_t)(row0 + ai * 128 + m * 16) * 1024 + gcol;
                    float rr[8], sb[8];
#pragma unroll
                    for (int n = 0; n < 2; ++n)
#pragma unroll
                        for (int j = 0; j < 4; ++j) { const float ea = 1.0f + __expf(-acc[ai][0][m][n][j]), eb = 1.0f + __expf(-acc[ai][1][m][n][j]);
                            sb[4 * n + j] = __builtin_amdgcn_rcpf(eb); rr[4 * n + j] = eb * __builtin_amdgcn_rcpf(ea); }
                    u32x4 w; w.x = pk2(rr[0], rr[1]); w.y = pk2(rr[2], rr[3]); w.z = pk2(rr[4], rr[5]); w.w = pk2(rr[6], rr[7]); *(u32x4*)(RB + off) = w;
                    w.x = pk2(sb[0], sb[1]); w.y = pk2(sb[2], sb[3]); w.z = pk2(sb[4], sb[5]); w.w = pk2(sb[6], sb[7]); *(u32x4*)(SB + off) = w;
                }
            return;
        }
#pragma unroll
        for (int ai = 0; ai < 2; ++ai)
#pragma unroll
            for (int m = 0; m < 4; ++m) {
                bf16_t* rowp = Z + (size_t)(row0 + ai * 128 + m * 16) * ZP + col0;
#pragma unroll
                for (int bj = 0; bj < 2; ++bj) { const f32x4 v0 = acc[ai][bj][m][0], v1 = acc[ai][bj][m][1];
                    u32x4 w; w.x = pk2(v0[0], v0[1]); w.y = pk2(v0[2], v0[3]); w.z = pk2(v1[0], v1[1]); w.w = pk2(v1[2], v1[3]);
                    *(u32x4*)(rowp + bj * 128) = w; }
            }
        if (u.pn <= 2) {
#pragma unroll
            for (int ai = 0; ai < 2; ++ai)
#pragma unroll
                for (int m = 0; m < 4; ++m) {
                    float s[2];
#pragma unroll
                    for (int bj = 0; bj < 2; ++bj) { const f32x4 v0 = acc[ai][bj][m][0], v1 = acc[ai][bj][m][1];
                        s[bj] = (v0[0] * v0[0] + v0[1] * v0[1]) + (v0[2] * v0[2] + v0[3] * v0[3]) + (v1[0] * v1[0] + v1[1] * v1[1]) + (v1[2] * v1[2] + v1[3] * v1[3]); }
                    float sq = 0.f, sk = 0.f;
                    if (u.pn == 0) sq = s[0] + s[1]; else if (u.pn == 1) { sq = s[0]; sk = s[1]; } else sk = s[0];
                    sq = sum_fq(sq); sk = sum_fq(sk);
                    const int row = row0 + ai * 128 + m * 16;
                    if (fq == 0) { if (u.pn <= 1) add_agent(ssq + row, sq); if (u.pn >= 1) add_agent(sskv + row, sk); }
                }
        }
    }
};
struct EpiRowScale {
    static constexpr bool PERM = true, AFTER_DRAIN = false, HAS_MID = false;
    bf16_t* O; int ldo; const float* ss; float invn; float scale;
    DI void operator()(const f32x4 (&acc)[2][2][4][2], const Unit& u, int wr, int wc, int fr, int fq) const {
        const int row0 = u.pm * 256 + wr * 64 + fr, col0 = u.pn * 256 + wc * 32 + 8 * fq;
        float ssv[2][4];
#pragma unroll
        for (int ai = 0; ai < 2; ++ai)
#pragma unroll
            for (int m = 0; m < 4; ++m) ssv[ai][m] = ld_agent(ss + row0 + ai * 128 + m * 16);
#pragma unroll
        for (int ai = 0; ai < 2; ++ai)
#pragma unroll
            for (int m = 0; m < 4; ++m) {
                const int row = row0 + ai * 128 + m * 16;
                const float rs = __builtin_amdgcn_rsqf(ssv[ai][m] * invn + EPS) * scale;
                bf16_t* rowp = O + (size_t)row * ldo + col0;
#pragma unroll
                for (int bj = 0; bj < 2; ++bj) { const f32x4 v0 = acc[ai][bj][m][0] * rs, v1 = acc[ai][bj][m][1] * rs;
                    u32x4 w; w.x = pk2(v0[0], v0[1]); w.y = pk2(v0[2], v0[3]); w.z = pk2(v1[0], v1[1]); w.w = pk2(v1[2], v1[3]);
                    *(u32x4*)(rowp + bj * 128) = w; }
            }
    }
};
struct EpiMix2 {
    static constexpr bool PERM = true, AFTER_DRAIN = false, HAS_MID = true;
    bf16_t* MIX; const bf16_t* RB; const bf16_t* SB;
    DI void mid(f32x4 (&acc)[2][2][4][2], const Unit& u, int wr, int wc, int fr, int fq) const {
        const int row0 = u.pm * 256 + wr * 64 + fr, col0 = u.pn * 256 + wc * 32 + 8 * fq;
#pragma unroll
        for (int ai = 0; ai < 2; ++ai)
#pragma unroll
            for (int m = 0; m < 4; ++m) {
                const bf16_t* gp = RB + (size_t)(row0 + ai * 128 + m * 16) * 1024 + col0;
#pragma unroll
                for (int bj = 0; bj < 2; ++bj) {
                    const u32x4 r = __builtin_nontemporal_load((const u32x4*)(gp + bj * 128));
#pragma unroll
                    for (int k = 0; k < 4; ++k) { acc[ai][bj][m][k >> 1][(k & 1) * 2] *= bflo(r[k]); acc[ai][bj][m][k >> 1][(k & 1) * 2 + 1] *= bfhi(r[k]); }
                }
                if (m & 1) asm volatile("" ::: "memory");
            }
    }
    DI void operator()(const f32x4 (&acc)[2][2][4][2], const Unit& u, int wr, int wc, int fr, int fq) const {
        const int row0 = u.pm * 256 + wr * 64 + fr, col0 = u.pn * 256 + wc * 32 + 8 * fq;
#pragma unroll
        for (int ai = 0; ai < 2; ++ai)
#pragma unroll
            for (int m = 0; m < 4; ++m) {
                const int row = row0 + ai * 128 + m * 16;
                bf16_t* rowp = MIX + (size_t)row * 1024 + col0; const bf16_t* gp = SB + (size_t)row * 1024 + col0;
#pragma unroll
                for (int bj = 0; bj < 2; ++bj) {
                    const u32x4 g = __builtin_nontemporal_load((const u32x4*)(gp + bj * 128));
                    const f32x4 a0 = acc[ai][bj][m][0], a1 = acc[ai][bj][m][1];
                    u32x4 w;
                    w.x = pk2(a0[0] * bflo(g.x), a0[1] * bfhi(g.x)); w.y = pk2(a0[2] * bflo(g.y), a0[3] * bfhi(g.y));
                    w.z = pk2(a1[0] * bflo(g.z), a1[1] * bfhi(g.z)); w.w = pk2(a1[2] * bflo(g.w), a1[3] * bfhi(g.w));
                    *(u32x4*)(rowp + bj * 128) = w;
                }
            }
    }
};
template <bool WB> struct EpiRes {
    static constexpr bool PERM = true, AFTER_DRAIN = false, HAS_MID = false;
    const float* base; float* out; bf16_t* ob; float* ss;
    DI void operator()(const f32x4 (&acc)[2][2][4][2], const Unit& u, int wr, int wc, int fr, int fq) const {
        const int row0 = u.pm * 256 + wr * 64 + fr, col0 = u.pn * 256 + wc * 32 + 8 * fq;
#pragma unroll
        for (int ai = 0; ai < 2; ++ai)
#pragma unroll
            for (int mp = 0; mp < 2; ++mp) {
                f32x4 bl[2][2][2];
#pragma unroll
                for (int mm = 0; mm < 2; ++mm) { const size_t off = (size_t)(row0 + ai * 128 + (2 * mp + mm) * 16) * 1024 + col0;
#pragma unroll
                    for (int bj = 0; bj < 2; ++bj) { bl[mm][bj][0] = __builtin_nontemporal_load((const f32x4*)(base + off + bj * 128)); bl[mm][bj][1] = __builtin_nontemporal_load((const f32x4*)(base + off + bj * 128 + 4)); } }
#pragma unroll
                for (int mm = 0; mm < 2; ++mm) { const int m = 2 * mp + mm;
                    const int row = row0 + ai * 128 + m * 16; const size_t off = (size_t)row * 1024 + col0; float s = 0.f;
#pragma unroll
                    for (int bj = 0; bj < 2; ++bj) {
                        const f32x4 v0 = bl[mm][bj][0] + acc[ai][bj][m][0], v1 = bl[mm][bj][1] + acc[ai][bj][m][1];
                        if (!WB) { *(f32x4*)(out + off + bj * 128) = v0; *(f32x4*)(out + off + bj * 128 + 4) = v1; }
                        s += (v0[0] * v0[0] + v0[1] * v0[1]) + (v0[2] * v0[2] + v0[3] * v0[3]) + (v1[0] * v1[0] + v1[1] * v1[1]) + (v1[2] * v1[2] + v1[3] * v1[3]);
                        if (WB) { u32x4 w; w.x = pk2(v0[0], v0[1]); w.y = pk2(v0[2], v0[3]); w.z = pk2(v1[0], v1[1]); w.w = pk2(v1[2], v1[3]); *(u32x4*)(ob + off + bj * 128) = w; }
                    }
                    s = sum_fq(s);
                    if (fq == 0) add_agent(ss + row, s);
                }
                asm volatile("" ::: "memory");
            }
    }
};
struct EpiResNorm {
    static constexpr bool PERM = true, AFTER_DRAIN = true, HAS_MID = false;
    const bf16_t* base; float* out; float* ss; const float* gain; unsigned* pcnt; unsigned* bar;
    DI void fused(f32x4 (&acc)[2][2][4][2], const Unit& u, int wr, int wc, int fr, int fq, LAS unsigned char* lds, int wid, int lane) const {
        const int row0 = u.pm * 256 + wr * 64 + fr, col0 = u.pn * 256 + wc * 32 + 8 * fq;
#pragma unroll
        for (int ai = 0; ai < 2; ++ai)
#pragma unroll
            for (int m = 0; m < 4; ++m) {
                const int row = row0 + ai * 128 + m * 16; const size_t off = (size_t)row * 1024 + col0; float s = 0.f;
#pragma unroll
                for (int bj = 0; bj < 2; ++bj) {
                    const u32x4 hb = *(const u32x4*)(base + off + bj * 128);
                    const f32x4 b0 = {bflo(hb.x), bfhi(hb.x), bflo(hb.y), bfhi(hb.y)}, b1 = {bflo(hb.z), bfhi(hb.z), bflo(hb.w), bfhi(hb.w)};
                    const f32x4 v0 = b0 + acc[ai][bj][m][0], v1 = b1 + acc[ai][bj][m][1];
                    acc[ai][bj][m][0] = v0; acc[ai][bj][m][1] = v1;
                    s += (v0[0] * v0[0] + v0[1] * v0[1]) + (v0[2] * v0[2] + v0[3] * v0[3]) + (v1[0] * v1[0] + v1[1] * v1[1]) + (v1[2] * v1[2] + v1[3] * v1[3]);
                }
                s = sum_fq(s);
                if (fq == 0) add_agent(ss + row, s);
                if (m & 1) asm volatile("" ::: "memory");
            }
        asm volatile("s_waitcnt vmcnt(0)" ::: "memory");
        __syncthreads();
        if (threadIdx.x == 0) { (void)xb_add(pcnt + 64 * u.pm, 1u); XB_SPIN(xb_ld(pcnt + 64 * u.pm) < 4u, bar); }
        __syncthreads();
        f32x4 gn[2][2];
#pragma unroll
        for (int bj = 0; bj < 2; ++bj) { gn[bj][0] = *(const f32x4*)(gain + col0 + bj * 128); gn[bj][1] = *(const f32x4*)(gain + col0 + bj * 128 + 4); }
        float ssv[2][4];
#pragma unroll
        for (int ai = 0; ai < 2; ++ai)
#pragma unroll
            for (int m = 0; m < 4; ++m) ssv[ai][m] = ld_agent(ss + row0 + ai * 128 + m * 16);
#pragma unroll
        for (int ai = 0; ai < 2; ++ai)
#pragma unroll
            for (int m = 0; m < 4; ++m) {
                const int row = row0 + ai * 128 + m * 16; const size_t off = (size_t)row * 1024 + col0;
                const float rs = __builtin_amdgcn_rsqf(ssv[ai][m] * (1.0f / 1024.0f) + EPS);
#pragma unroll
                for (int bj = 0; bj < 2; ++bj) { __builtin_nontemporal_store(acc[ai][bj][m][0] * rs * gn[bj][0], (f32x4*)(out + off + bj * 128)); __builtin_nontemporal_store(acc[ai][bj][m][1] * rs * gn[bj][1], (f32x4*)(out + off + bj * 128 + 4)); }
            }
    }
};
struct EpiFfn {
    static constexpr bool PERM = true, AFTER_DRAIN = false, HAS_MID = false;
    bf16_t* ACT; const float* ss;
    DI void operator()(const f32x4 (&acc)[2][2][4][2], const Unit& u, int wr, int wc, int fr, int fq) const {
        const int row0 = u.pm * 256 + wr * 64 + fr, col0 = u.pn * 128 + wc * 32 + 8 * fq;
        float ssv[2][4];
#pragma unroll
        for (int ai = 0; ai < 2; ++ai)
#pragma unroll
            for (int m = 0; m < 4; ++m) ssv[ai][m] = ld_agent(ss + row0 + ai * 128 + m * 16);
#pragma unroll
        for (int ai = 0; ai < 2; ++ai)
#pragma unroll
            for (int m = 0; m < 4; ++m) {
                const int row = row0 + ai * 128 + m * 16;
                const float rs = __builtin_amdgcn_rsqf(ssv[ai][m] * (1.0f / 1024.0f) + EPS);
                float v[8];
#pragma unroll
                for (int n = 0; n < 2; ++n)
#pragma unroll
                    for (int j = 0; j < 4; ++j) { const float g = acc[ai][0][m][n][j] * rs, up = acc[ai][1][m][n][j] * rs; v[n * 4 + j] = g * sigmoidf_(g) * up; }
                u32x4 w; w.x = pk2(v[0], v[1]); w.y = pk2(v[2], v[3]); w.z = pk2(v[4], v[5]); w.w = pk2(v[6], v[7]);
                *(u32x4*)(ACT + (size_t)row * DFF + col0) = w;
            }
    }
};

DI float wave_sum(float v) {
    v += __builtin_bit_cast(float, __builtin_amdgcn_update_dpp(0, __builtin_bit_cast(int, v), 0xB1, 0xF, 0xF, false));
    v += __builtin_bit_cast(float, __builtin_amdgcn_update_dpp(0, __builtin_bit_cast(int, v), 0x4E, 0xF, 0xF, false));
    v += __builtin_bit_cast(float, __builtin_amdgcn_update_dpp(0, __builtin_bit_cast(int, v), 0x141, 0xF, 0xF, false));
    v += __builtin_bit_cast(float, __builtin_amdgcn_update_dpp(0, __builtin_bit_cast(int, v), 0x140, 0xF, 0xF, false));
    return sum_fq(v);
}
DI void transpose_item(const float* __restrict__ W, int K, int N, const float* __restrict__ ksc, bf16_t* __restrict__ WT, int dst_row0, int k0, int n0, float* scr, int lane, int ldw = 0, int kofs = 0, int dst_row16 = -1) {
    if (ldw == 0) ldw = K;
    if (dst_row16 < 0) dst_row16 = dst_row0 + 16;
    const int nq = n0 + 4 * (lane & 7), kr = lane >> 3;
    f32x4 v[8];
#pragma unroll
    for (int i = 0; i < 8; ++i) v[i] = (nq < N) ? __builtin_nontemporal_load((const f32x4*)(W + (size_t)(k0 + 8 * i + kr) * N + nq)) : (f32x4){0.f, 0.f, 0.f, 0.f};
#pragma unroll
    for (int i = 0; i < 8; ++i) { const int kk = 8 * i + kr; const float sc = ksc ? ksc[k0 + kk] : 1.0f; float* d = scr + kk * 33 + 4 * (lane & 7);
        d[0] = v[i].x * sc; d[1] = v[i].y * sc; d[2] = v[i].z * sc; d[3] = v[i].w * sc; }
    asm volatile("s_waitcnt lgkmcnt(0)" ::: "memory");
    const int c = lane & 7;
#pragma unroll
    for (int j = 0; j < 4; ++j) { const int nn = (lane >> 3) + 8 * j; const float* s = scr + (8 * c) * 33 + nn;
        u32x4 o; o.x = pk2(s[0 * 33], s[1 * 33]); o.y = pk2(s[2 * 33], s[3 * 33]); o.z = pk2(s[4 * 33], s[5 * 33]); o.w = pk2(s[6 * 33], s[7 * 33]);
        *(u32x4*)(WT + (size_t)(nn < 16 ? dst_row0 + nn : dst_row16 + nn - 16) * ldw + kofs + k0 + 8 * c) = o; }
    asm volatile("s_waitcnt lgkmcnt(0)" ::: "memory");
}
DI int win_row(int c) { return c < 2224 ? c : c < 3248 ? 2304 + 256 * ((c - 2224) >> 7) + ((c - 2224) & 127) : c < 4272 ? 2304 + 256 * ((c - 3248) >> 7) + 128 + ((c - 3248) & 127) : 2224 + (c - 4272); }
constexpr int I_IN = 16 * 136, I_UQ = 6 * 24, I_UKV = 4 * 32, I_OA = 8 * 32, I_OUT = 16 * 32, I_F = 16 * 88, I_D = 44 * 32;
constexpr int NITEMS_EARLY = I_IN + I_UQ + I_UKV;
constexpr int NITEMS = NITEMS_EARLY + 2 * I_OA + I_OUT + 2 * I_F + I_D;
DI void weight_items(const Params& P, unsigned char* lds, int it_lo, int it_hi, int gw, int NGW) {
    const int lane = threadIdx.x & 63, wave = threadIdx.x >> 6;
    float* scr = (float*)(lds + wave * 16384);
    unsigned char* ws = P.ws;
    for (int it = it_lo + gw; it < it_hi; it += NGW) {
        int r = it;
        if (r < I_IN) { const int kb = r / 136, nb = r % 136; if (nb * 32 >= DIN) continue;
            transpose_item(P.w_in, 1024, DIN, nullptr, (bf16_t*)(ws + WS_WIN), win_row(nb * 32), kb * 64, nb * 32, scr, lane, 0, 0, win_row(nb * 32 + 16)); continue; } r -= I_IN;
        if (r < I_UQ) { const int kb = r / 24, nb = r % 24; transpose_item(P.w_uq, 384, 768, P.norm_cq, (bf16_t*)(ws + WS_WUQ), nb * 32, kb * 64, nb * 32, scr, lane); continue; } r -= I_UQ;
        if (r < I_UKV) { const int kb = r / 32, nb = r % 32; transpose_item(P.w_ukv, 256, 1024, P.norm_ckv, (bf16_t*)(ws + WS_WUKV), nb * 32, kb * 64, nb * 32, scr, lane); continue; } r -= I_UKV;
        if (r < I_OA) { const int kb = r / 32, nb = r % 32; transpose_item(P.w_oa, 512, 1024, nullptr, (bf16_t*)(ws + WS_WOA), nb * 32, kb * 64, nb * 32, scr, lane, 1024, 0); continue; } r -= I_OA;
        if (r < I_OA) { const int kb = r / 32, nb = r % 32; transpose_item(P.w_ob, 512, 1024, nullptr, (bf16_t*)(ws + WS_WOA), nb * 32, kb * 64, nb * 32, scr, lane, 1024, 512); continue; } r -= I_OA;
        if (r < I_OUT) { const int kb = r / 32, nb = r % 32; transpose_item(P.w_out, 1024, 1024, nullptr, (bf16_t*)(ws + WS_WOUT), nb * 32, kb * 64, nb * 32, scr, lane); continue; } r -= I_OUT;
        if (r < I_F) { const int kb = r / 88, nb = r % 88, n0 = nb * 32; transpose_item(P.w_fg, 1024, DFF, P.ln_ffn, (bf16_t*)(ws + WS_WGU), 256 * (n0 >> 7) + (n0 & 127), kb * 64, n0, scr, lane); continue; } r -= I_F;
        if (r < I_F) { const int kb = r / 88, nb = r % 88, n0 = nb * 32; transpose_item(P.w_fu, 1024, DFF, P.ln_ffn, (bf16_t*)(ws + WS_WGU), 256 * (n0 >> 7) + 128 + (n0 & 127), kb * 64, n0, scr, lane); continue; } r -= I_F;
        { const int kb = r / 32, nb = r % 32; transpose_item(P.w_fd, DFF, 1024, nullptr, (bf16_t*)(ws + WS_WD), nb * 32, kb * 64, nb * 32, scr, lane); }
    }
}
DI void phase0(const Params& P, unsigned char* lds) {
    const int tid = threadIdx.x, lane = tid & 63, wave = tid >> 6;
    const int gw = blockIdx.x * 8 + wave, NGW = gridDim.x * 8;
    unsigned char* ws = P.ws;
    weight_items(P, lds, 0, NITEMS_EARLY, gw, NGW);
    bf16_t* U = (bf16_t*)(ws + WS_U);
    for (int m = 4 * gw; m < NTOK; m += 4 * NGW) {
        const f32x4* xr = (const f32x4*)(P.x + (size_t)m * DM) + lane; const f32x4* wr_ = (const f32x4*)P.ln_mix + lane;
        f32x4 v[4][4]; float ss4[4] = {0.f, 0.f, 0.f, 0.f};
#pragma unroll
        for (int q = 0; q < 4; ++q)
#pragma unroll
            for (int j = 0; j < 4; ++j) v[q][j] = __builtin_nontemporal_load(xr + 256 * q + 64 * j);
#pragma unroll
        for (int q = 0; q < 4; ++q)
#pragma unroll
            for (int j = 0; j < 4; ++j) ss4[q] += (v[q][j].x * v[q][j].x + v[q][j].y * v[q][j].y) + (v[q][j].z * v[q][j].z + v[q][j].w * v[q][j].w);
        float rq[4];
#pragma unroll
        for (int q = 0; q < 4; ++q) rq[q] = __builtin_amdgcn_rsqf(wave_sum(ss4[q]) * (1.0f / DM) + EPS);
        u32x2* o8 = (u32x2*)(U + (size_t)m * DM) + lane;
#pragma unroll
        for (int j = 0; j < 4; ++j) { const f32x4 g = wr_[64 * j];
#pragma unroll
            for (int q = 0; q < 4; ++q) { u32x2 w; w.x = pk2(v[q][j].x * rq[q] * g.x, v[q][j].y * rq[q] * g.y); w.y = pk2(v[q][j].z * rq[q] * g.z, v[q][j].w * rq[q] * g.w); o8[256 * q + 64 * j] = w; } }
    }
    const int gt = blockIdx.x * NTHREADS + tid, NGT = gridDim.x * NTHREADS;
    float* cs = (float*)(ws + WS_COS); float* sn = (float*)(ws + WS_SIN);
    for (int e = gt; e < NTOK * 16; e += NGT) {
        const int row = e >> 4, i = e & 15;
        const float inv = exp2f(-(float)i * (13.287712379549449f / 16.0f));
        const float ang = (float)P.pos[row] * inv;
        float rev = ang * 0.15915494309189535f; rev = rev - floorf(rev);
        cs[e] = __builtin_amdgcn_cosf(rev); sn[e] = __builtin_amdgcn_sinf(rev);
    }
    float* ss = (float*)(ws + WS_SS);
    for (int e = gt; e < 4 * NTOK; e += NGT) ss[e] = 0.f;
}

struct GlaARaw { bf16_t k[8]; u32x4 v[2]; u32x4 g; float w[16]; float bias; };
#define GLA_A_LOAD(UNIT, R) do { const int h_ = (UNIT) & 3, n_ = ((UNIT) >> 2) & 31, b_ = (UNIT) >> 7, t_ = b_ * SEQ + 64 * n_; \
    _Pragma("unroll") for (int r = 0; r < 16; ++r) R.w[r] = P.w_gate2[r * 256 + 64 * h_ + lane]; \
    R.bias = P.b_gate[64 * h_ + lane]; \
    R.g = *(const u32x4*)(Zg + (size_t)(t_ + 8 * w + ((lane & 15) >> 1)) * ZP + ZC_GLR + 8 * (lane & 1)); \
    _Pragma("unroll") for (int i = 0; i < 8; ++i) R.k[i] = Zg[(size_t)(t_ + 8 * w + i) * ZP + ZC_GK + 64 * h_ + lane]; \
    _Pragma("unroll") for (int c2 = 0; c2 < 2; ++c2) { const int ch = tid + 512 * c2; R.v[c2] = *(const u32x4*)(Zg + (size_t)(t_ + (ch >> 4)) * ZP + ZC_GV + 128 * h_ + 8 * (ch & 15)); } } while (0)
DI void gla_gate(const u32x4 g, const float (&w)[16], float bias, int seg, int d, float* segsum, float (&b)[8], float& blast) {
    float c = 0.f;
#pragma unroll
    for (int i = 0; i < 8; ++i) {
        float x = bias;
#pragma unroll
        for (int hf = 0; hf < 2; ++hf)
#pragma unroll
            for (int k = 0; k < 4; ++k) { const unsigned wv = (unsigned)__builtin_amdgcn_readlane((int)g[k], 2 * i + hf); x += bflo(wv) * w[8 * hf + 2 * k] + bfhi(wv) * w[8 * hf + 2 * k + 1]; }
        const float ls = fminf(x, 0.f) - __logf(1.0f + __expf(-fabsf(x)));
        c += ls * (1.0f / 16.0f); b[i] = c;
    }
    segsum[seg * 64 + d] = c;
    __syncthreads();
    float pre = 0.f, tot = 0.f;
#pragma unroll
    for (int s = 0; s < 8; ++s) { const float v = segsum[s * 64 + d]; tot += v; if (s < seg) pre += v; }
#pragma unroll
    for (int i = 0; i < 8; ++i) b[i] += pre;
    blast = tot;
}
DI void gla_load_v(const bf16_t* Z, int t0, int h, bf16_t* Vs, int tid) {
#pragma unroll
    for (int c2 = 0; c2 < 2; ++c2) { const int ch = tid + 512 * c2, t = ch >> 4, c = ch & 15;
        *(u32x4*)(Vs + t * 160 + 8 * c) = *(const u32x4*)(Z + (size_t)(t0 + t) * ZP + ZC_GV + 128 * h + 8 * c); }
}
DI void gla_a_unit(const Params& P, int unit, int next_unit, bool has_next, unsigned char* lds, GlaARaw& io) {
    const int tid = threadIdx.x, lane = tid & 63, w = __builtin_amdgcn_readfirstlane(tid >> 6);
    const int h = unit & 3, n = (unit >> 2) & 31, bb = unit >> 7, t0 = bb * SEQ + 64 * n, bh = bb * 4 + h;
    const bf16_t* Zg = (const bf16_t*)(P.ws + WS_Z);
    float* segsum = (float*)lds; bf16_t* kdT = (bf16_t*)(lds + 2048); bf16_t* Vs = (bf16_t*)(lds + 11264);
    bf16_t kraw[8]; u32x4 vraw[2]; float wg[16];
#pragma unroll
    for (int i = 0; i < 8; ++i) kraw[i] = io.k[i];
#pragma unroll
    for (int r = 0; r < 16; ++r) wg[r] = io.w[r];
    vraw[0] = io.v[0]; vraw[1] = io.v[1];
    const u32x4 gcur = io.g; const float biasc = io.bias;
    if (has_next) GLA_A_LOAD(next_unit, io);
    float b[8], blast;
    gla_gate(gcur, wg, biasc, w, lane, segsum, b, blast);
    float kd[8];
#pragma unroll
    for (int i = 0; i < 8; ++i) kd[i] = bf2f(kraw[i]) * __expf(blast - b[i]);
    *(bf16x8*)(kdT + lane * 72 + 8 * w) = pack8(kd[0], kd[1], kd[2], kd[3], kd[4], kd[5], kd[6], kd[7]);
    if (w == 0) ((float*)(P.ws + WS_DEC))[(bh * 32 + n) * 64 + lane] = __expf(blast);
    { float* BC = (float*)(P.ws + WS_OM);
#pragma unroll
      for (int i = 0; i < 8; ++i) BC[(size_t)(t0 + 8 * w + i) * 256 + 64 * h + lane] = b[i]; }
#pragma unroll
    for (int c2 = 0; c2 < 2; ++c2) { const int ch = tid + 512 * c2; *(u32x4*)(Vs + (ch >> 4) * 160 + 8 * (ch & 15)) = vraw[c2]; }
    __syncthreads();
    const int r32 = lane & 31, hi = lane >> 5, g1 = (lane >> 4) & 1, q4 = (lane & 15) >> 2, p = lane & 3, dh = w & 1, eb = w >> 1;
    f32x16 acc = {};
#pragma unroll
    for (int ks = 0; ks < 4; ++ks) {
        const bf16x8 a = *(const bf16x8*)(kdT + (32 * dh + r32) * 72 + 16 * ks + 8 * hi);
        const bf16_t* vp = Vs + (16 * ks + 8 * hi + q4) * 160 + 32 * eb + 16 * g1 + 4 * p;
        const bf16x8 bv = cat8(tr_read(vp), tr_read(vp + 4 * 160));
        acc = MFMA32(a, bv, acc);
    }
    bf16_t* ST = (bf16_t*)P.out + ((size_t)(bh * 32 + n) * 128 + 32 * eb + r32) * 64 + 32 * dh + 4 * hi;
#pragma unroll
    for (int rg = 0; rg < 4; ++rg) { u32x2 o; o.x = pk2(acc[4 * rg], acc[4 * rg + 1]); o.y = pk2(acc[4 * rg + 2], acc[4 * rg + 3]); *(u32x2*)(ST + 8 * rg) = o; }
    __syncthreads();
}
DI void gla_scan(const Params& P) {
    const int gt = blockIdx.x * NTHREADS + threadIdx.x, NGT = gridDim.x * NTHREADS;
    const unsigned* ST = (const unsigned*)P.out; unsigned* ST2 = (unsigned*)P.out; const f32x2* DEC = (const f32x2*)(P.ws + WS_DEC);
    for (int item = gt; item < 32 * 128 * 32; item += NGT) {
        const int dp = item & 31, e = (item >> 5) & 127, bh = item >> 12;
        unsigned kv[32]; f32x2 dc[32];
        const size_t idx0 = ((size_t)(bh * 32) * 128 + e) * 32 + dp;
#pragma unroll
        for (int n = 0; n < 32; ++n) { kv[n] = __builtin_nontemporal_load(ST + idx0 + (size_t)n * 128 * 32); dc[n] = DEC[(bh * 32 + n) * 32 + dp]; }
        float s0 = 0.f, s1 = 0.f;
#pragma unroll
        for (int n = 0; n < 32; ++n) { ST2[idx0 + (size_t)n * 128 * 32] = pk2(s0, s1); s0 = dc[n].x * s0 + bflo(kv[n]); s1 = dc[n].y * s1 + bfhi(kv[n]); }
    }
}
struct GlaCRaw { bf16_t q[8], k[8]; u32x4 v[2]; float b[8]; bf16x8 sf[4]; bf16_t og[16]; };
#define GLA_C_LOAD(UNIT, R) do { const int h_ = (UNIT) & 3, n_ = ((UNIT) >> 2) & 31, b_ = (UNIT) >> 7, t_ = b_ * SEQ + 64 * n_, bh_ = b_ * 4 + h_; \
    _Pragma("unroll") for (int i = 0; i < 8; ++i) { const size_t zr = (size_t)(t_ + 8 * w + i) * ZP + 64 * h_ + lane; R.q[i] = Zg[zr + ZC_GQ]; R.k[i] = Zg[zr + ZC_GK]; R.b[i] = BCg[(size_t)(t_ + 8 * w + i) * 256 + 64 * h_ + lane]; } \
    { const bf16_t* ST_ = (const bf16_t*)P.out + ((size_t)(bh_ * 32 + n_) * 128 + 32 * eb + r32) * 64 + 8 * hi; \
      _Pragma("unroll") for (int ds = 0; ds < 4; ++ds) R.sf[ds] = *(const bf16x8*)(ST_ + 16 * ds); \
      _Pragma("unroll") for (int r = 0; r < 16; ++r) R.og[r] = Zg[(size_t)(t_ + 32 * ih + (r & 3) + 8 * (r >> 2) + 4 * hi) * ZP + ZC_OG + 128 * h_ + 32 * eb + r32]; } \
    _Pragma("unroll") for (int c2 = 0; c2 < 2; ++c2) { const int ch = tid + 512 * c2; R.v[c2] = *(const u32x4*)(Zg + (size_t)(t_ + (ch >> 4)) * ZP + ZC_GV + 128 * h_ + 8 * (ch & 15)); } } while (0)
DI void gla_c_unit(const Params& P, int unit, int next_unit, bool has_next, unsigned char* lds, GlaCRaw& io, float gn) {
    const int tid = threadIdx.x, lane = tid & 63, w = __builtin_amdgcn_readfirstlane(tid >> 6);
    const int h = unit & 3, n = (unit >> 2) & 31, bb = unit >> 7, t0 = bb * SEQ + 64 * n;
    const bf16_t* Z = (const bf16_t*)(P.ws + WS_Z); const bf16_t* Zg = Z; const float* BCg = (const float*)(P.ws + WS_OM);
    bf16_t* qe_s = (bf16_t*)(lds + 2048); bf16_t* ke_s = (bf16_t*)(lds + 11264); bf16_t* Vs = (bf16_t*)(lds + 20480); float* red = (float*)(lds + 40960);
    const int r32 = lane & 31, hi = lane >> 5, g1 = (lane >> 4) & 1, q4 = (lane & 15) >> 2, p = lane & 3, ih = w & 1, eb = w >> 1;
    bf16_t qraw[8], kraw[8]; u32x4 vraw[2]; float b[8]; bf16x8 sf[4]; bf16_t ograw[16];
#pragma unroll
    for (int i = 0; i < 8; ++i) { qraw[i] = io.q[i]; kraw[i] = io.k[i]; b[i] = io.b[i]; }
    vraw[0] = io.v[0]; vraw[1] = io.v[1];
#pragma unroll
    for (int ds = 0; ds < 4; ++ds) sf[ds] = io.sf[ds];
#pragma unroll
    for (int r = 0; r < 16; ++r) ograw[r] = io.og[r];
    if (has_next) GLA_C_LOAD(next_unit, io);
#pragma unroll
    for (int i = 0; i < 8; ++i) {
        const float q = bf2f(qraw[i]), k = bf2f(kraw[i]);
        const unsigned pq = pk2(q * 0.125f * __expf(b[i]), k * __expf(-b[i]));
        qe_s[(8 * w + i) * 72 + lane] = (bf16_t)(pq & 0xffffu); ke_s[(8 * w + i) * 72 + lane] = (bf16_t)(pq >> 16);
    }
#pragma unroll
    for (int c2 = 0; c2 < 2; ++c2) { const int ch = tid + 512 * c2; *(u32x4*)(Vs + (ch >> 4) * 160 + 8 * (ch & 15)) = vraw[c2]; }
    __syncthreads();
    bf16x8 qf[4];
#pragma unroll
    for (int ds = 0; ds < 4; ++ds) qf[ds] = *(const bf16x8*)(qe_s + (32 * ih + r32) * 72 + 16 * ds + 8 * hi);
    f32x16 x0 = {}, x1 = {};
#pragma unroll
    for (int ds = 0; ds < 4; ++ds) x0 = MFMA32(*(const bf16x8*)(ke_s + r32 * 72 + 16 * ds + 8 * hi), qf[ds], x0);
    if (ih == 1) {
#pragma unroll
        for (int ds = 0; ds < 4; ++ds) x1 = MFMA32(*(const bf16x8*)(ke_s + (32 + r32) * 72 + 16 * ds + 8 * hi), qf[ds], x1);
    }
#pragma unroll
    for (int r = 0; r < 16; ++r) { const int j = (r & 3) + 8 * (r >> 2) + 4 * hi; if (j > r32) { if (ih == 0) x0[r] = 0.f; else x1[r] = 0.f; } }
    f32x16 o = {};
#pragma unroll
    for (int s = 0; s < 2; ++s) {
        const bf16x8 pf = pack8(x0[8 * s], x0[8 * s + 1], x0[8 * s + 2], x0[8 * s + 3], x0[8 * s + 4], x0[8 * s + 5], x0[8 * s + 6], x0[8 * s + 7]);
        const bf16_t* vp = Vs + (16 * s + 4 * hi + q4) * 160 + 32 * eb + 16 * g1 + 4 * p;
        o = MFMA32(pf, cat8(tr_read(vp), tr_read(vp + 8 * 160)), o);
    }
    if (ih == 1) {
#pragma unroll
        for (int s = 0; s < 2; ++s) {
            const bf16x8 pf = pack8(x1[8 * s], x1[8 * s + 1], x1[8 * s + 2], x1[8 * s + 3], x1[8 * s + 4], x1[8 * s + 5], x1[8 * s + 6], x1[8 * s + 7]);
            const bf16_t* vp = Vs + (32 + 16 * s + 4 * hi + q4) * 160 + 32 * eb + 16 * g1 + 4 * p;
            o = MFMA32(pf, cat8(tr_read(vp), tr_read(vp + 8 * 160)), o);
        }
    }
#pragma unroll
    for (int ds = 0; ds < 4; ++ds) o = MFMA32(qf[ds], sf[ds], o);
    float sq[16];
#pragma unroll
    for (int r = 0; r < 16; ++r) {
        float v = o[r] * o[r];
        v += __builtin_bit_cast(float, __builtin_amdgcn_update_dpp(0, __builtin_bit_cast(int, v), 0xB1, 0xF, 0xF, false));
        v += __builtin_bit_cast(float, __builtin_amdgcn_update_dpp(0, __builtin_bit_cast(int, v), 0x4E, 0xF, 0xF, false));
        v += __builtin_bit_cast(float, __builtin_amdgcn_update_dpp(0, __builtin_bit_cast(int, v), 0x141, 0xF, 0xF, false));
        v += __builtin_bit_cast(float, __builtin_amdgcn_update_dpp(0, __builtin_bit_cast(int, v), 0x140, 0xF, 0xF, false));
        v += __builtin_bit_cast(float, __builtin_amdgcn_update_dpp(0, __builtin_bit_cast(int, v), 0x142, 0xA, 0xF, false));
        sq[r] = v; }
    if (r32 == 16) {
#pragma unroll
        for (int r = 0; r < 16; ++r) red[eb * 64 + 32 * ih + (r & 3) + 8 * (r >> 2) + 4 * hi] = sq[r];
    }
    __syncthreads();
    bf16_t* GO = (bf16_t*)P.out + 16 * MiB / 2;
#pragma unroll
    for (int r = 0; r < 16; ++r) {
        const int i = 32 * ih + (r & 3) + 8 * (r >> 2) + 4 * hi;
        const float tot = red[i] + red[64 + i] + red[128 + i] + red[192 + i];
        const float rs = __builtin_amdgcn_rsqf(tot * (1.0f / 128.0f) + EPS);
        const float og = bf2f(ograw[r]);
        const float v = o[r] * rs * gn * (og * sigmoidf_(og));
        GO[(size_t)(t0 + i) * 1024 + 512 + 128 * h + 32 * eb + r32] = (bf16_t)(pk2(v, 0.f) & 0xffffu);
    }
    __syncthreads();
}

DI void attn_unit(const Params& P, int bb, int h, int qb, unsigned char* lds) {
    const int tid = threadIdx.x, lane = tid & 63, w = __builtin_amdgcn_readfirstlane(tid >> 6);
    const int r32 = lane & 31, hi = lane >> 5, g1 = (lane >> 4) & 1, q4 = (lane & 15) >> 2, p = lane & 3;
    bf16_t* Ks = (bf16_t*)lds; bf16_t* Vs = (bf16_t*)(lds + 26624); float* wsf = (float*)(lds + 63488) + w * 32;
    const bf16_t* Q = (const bf16_t*)(P.ws + WS_U); const bf16_t* KV = (const bf16_t*)(P.ws + WS_KV); const bf16_t* KR = (const bf16_t*)(P.ws + WS_KR);
    bf16_t* OM = (bf16_t*)P.out + 16 * MiB / 2;
    const int q0 = qb * 256, qw0 = q0 + 32 * w, myq = qw0 + r32; const size_t rowb = (size_t)bb * SEQ;
    bf16x8 qf[6];
    { const bf16_t* qp = Q + (rowb + myq) * 768 + h * 96 + 8 * hi;
#pragma unroll
      for (int d0 = 0; d0 < 6; ++d0) qf[d0] = __builtin_nontemporal_load((const bf16x8*)(qp + 16 * d0));
      const float* cp = (const float*)(P.ws + WS_COS) + (rowb + myq) * 16 + 8 * hi; const float* sp = (const float*)(P.ws + WS_SIN) + (rowb + myq) * 16 + 8 * hi;
      const f32x4 c0 = *(const f32x4*)cp, c1 = *(const f32x4*)(cp + 4), s0 = *(const f32x4*)sp, s1 = *(const f32x4*)(sp + 4);
      const u32x4 a = __builtin_bit_cast(u32x4, qf[4]), b = __builtin_bit_cast(u32x4, qf[5]); u32x4 ra, rb;
#pragma unroll
      for (int k = 0; k < 4; ++k) { const float x1l = bflo(a[k]), x1h = bfhi(a[k]), x2l = bflo(b[k]), x2h = bfhi(b[k]);
          const float cl = k < 2 ? c0[2 * k] : c1[2 * k - 4], ch = k < 2 ? c0[2 * k + 1] : c1[2 * k - 3], sl = k < 2 ? s0[2 * k] : s1[2 * k - 4], sh = k < 2 ? s0[2 * k + 1] : s1[2 * k - 3];
          ra[k] = pk2(x1l * cl - x2l * sl, x1h * ch - x2h * sh); rb[k] = pk2(x2l * cl + x1l * sl, x2h * ch + x1h * sh); }
      qf[4] = __builtin_bit_cast(bf16x8, ra); qf[5] = __builtin_bit_cast(bf16x8, rb); }
    const int NT = (q0 + 256) / 64;
    const int kkey = tid >> 3, kc = tid & 7, rkey = (tid >> 2) & 63, rc = tid & 3;
    const bf16_t* ksrc = KV + (rowb + kkey) * 1024 + h * 128 + kc * 8;
    const bf16_t* rsrc = KR + (rowb + rkey) * 32 + rc * 8;
    u32x4 kreg, vreg, rreg = {};
#define ATT_LOAD(t) do { kreg = *(const u32x4*)(ksrc + (size_t)(t) * 64 * 1024); vreg = *(const u32x4*)(ksrc + (size_t)(t) * 64 * 1024 + 64); if (w < 4) rreg = *(const u32x4*)(rsrc + (size_t)(t) * 64 * 32); } while (0)
#define ATT_STORE(buf, vbuf) do { *(u32x4*)(Ks + (buf) * 6656 + kkey * 104 + kc * 8) = kreg; *(u32x4*)(Vs + (vbuf) * 6144 + kkey * 96 + kc * 8) = vreg; if (w < 4) *(u32x4*)(Ks + (buf) * 6656 + rkey * 104 + 64 + rc * 8) = rreg; } while (0)
#define ATT_PV(VB) do { const bf16_t* Vb_ = Vs + (VB) * 6144; __builtin_amdgcn_s_setprio(1); _Pragma("unroll") for (int s = 0; s < 4; ++s) { const bf16_t* vp = Vb_ + (16 * s + 4 * hi + q4) * 96 + 16 * g1 + 4 * p; \
        o0 = MFMA32(cat8(tr_read(vp), tr_read(vp + 8 * 96)), pf[s], o0); o1 = MFMA32(cat8(tr_read(vp + 32), tr_read(vp + 8 * 96 + 32)), pf[s], o1); } __builtin_amdgcn_s_setprio(0); } while (0)
    ATT_LOAD(0); ATT_STORE(0, 0);
    __syncthreads();
    float mrow = -INFINITY, lsum = 0.f; f32x16 o0 = {}, o1 = {};
    bf16x8 pf[4] = {}; bool pending = false; const bool grpB = (w >= 4);
    int vcur = 0, vprev = 2, vnext = 1;
    for (int t = 0; t < NT; ++t) {
        if (t + 1 < NT) ATT_LOAD(t + 1);
        if (grpB && pending) { ATT_PV(vprev); pending = false; }
        if (64 * t <= qw0 + 31) {
            const bf16_t* Kb = Ks + (t & 1) * 6656;
            f32x16 p0 = {}, p1 = {};
            __builtin_amdgcn_s_setprio(1);
#pragma unroll
            for (int d0 = 0; d0 < 6; ++d0) {
                const bf16x8 ka = *(const bf16x8*)(Kb + r32 * 104 + 16 * d0 + 8 * hi), kb = *(const bf16x8*)(Kb + (32 + r32) * 104 + 16 * d0 + 8 * hi);
                p0 = MFMA32(ka, qf[d0], p0); p1 = MFMA32(kb, qf[d0], p1);
            }
            __builtin_amdgcn_s_setprio(0);
            if (64 * t + 63 > qw0) {
#pragma unroll
                for (int r = 0; r < 16; ++r) { const int key = 64 * t + (r & 3) + 8 * (r >> 2) + 4 * hi; if (key > myq) p0[r] = -INFINITY; if (key + 32 > myq) p1[r] = -INFINITY; }
            }
            float mx = fmaxf(p0[0], p1[0]);
#pragma unroll
            for (int r = 1; r < 16; ++r) mx = __builtin_fmaxf(__builtin_fmaxf(mx, p0[r]), p1[r]);
            { const auto rr = __builtin_amdgcn_permlane32_swap(__float_as_uint(mx), __float_as_uint(mx), false, false);
              mx = fmaxf(__uint_as_float(rr[0]), __uint_as_float(rr[1])); }
            if (__any(mx > mrow + 8.0f)) {
                const float mnew = fmaxf(mrow, mx), alpha = __builtin_amdgcn_exp2f(mrow - mnew);
                mrow = mnew; lsum *= alpha;
#pragma unroll
                for (int r = 0; r < 16; ++r) { o0[r] *= alpha; o1[r] *= alpha; }
            }
            float rs = 0.f;
#pragma unroll
            for (int r = 0; r < 16; ++r) { p0[r] = __builtin_amdgcn_exp2f(p0[r] - mrow); p1[r] = __builtin_amdgcn_exp2f(p1[r] - mrow); rs += p0[r] + p1[r]; }
            lsum += rs;
            pf[0] = pack8(p0[0], p0[1], p0[2], p0[3], p0[4], p0[5], p0[6], p0[7]); pf[1] = pack8(p0[8], p0[9], p0[10], p0[11], p0[12], p0[13], p0[14], p0[15]);
            pf[2] = pack8(p1[0], p1[1], p1[2], p1[3], p1[4], p1[5], p1[6], p1[7]); pf[3] = pack8(p1[8], p1[9], p1[10], p1[11], p1[12], p1[13], p1[14], p1[15]);
            if (!grpB) ATT_PV(vcur); else pending = true;
        }
        if (t + 1 < NT) ATT_STORE((t + 1) & 1, vnext);
        __syncthreads();
        vprev = vcur; vcur = vnext; vnext = (vnext == 2) ? 0 : vnext + 1;
    }
    if (grpB && pending) ATT_PV(vprev);
#undef ATT_LOAD
#undef ATT_STORE
#undef ATT_PV
    lsum = sum_half(lsum);
    {
      const float inv = 1.0f / lsum; bf16_t* orow = OM + (rowb + myq) * 1024 + h * 64 + 8 * hi;
#pragma unroll
      for (int pr = 0; pr < 2; ++pr)
#pragma unroll
          for (int blk = 0; blk < 2; ++blk) {
              const f32x16& o = blk ? o1 : o0; const int g = 2 * pr;
              const unsigned a0 = pk2(o[4 * g] * inv, o[4 * g + 1] * inv), a1 = pk2(o[4 * g + 2] * inv, o[4 * g + 3] * inv);
              const unsigned b0 = pk2(o[4 * g + 4] * inv, o[4 * g + 5] * inv), b1 = pk2(o[4 * g + 6] * inv, o[4 * g + 7] * inv);
              const auto s0 = __builtin_amdgcn_permlane32_swap(a0, b0, false, false), s1 = __builtin_amdgcn_permlane32_swap(a1, b1, false, false);
              u32x4 wv; wv.x = s0[0]; wv.y = s1[0]; wv.z = s0[1]; wv.w = s1[1];
              *(u32x4*)(orow + 32 * blk + 16 * pr) = wv; } }
    __syncthreads();
}


__global__ void __launch_bounds__(NTHREADS, 2) hybrid_fwd(Params P) {
    extern __shared__ __attribute__((aligned(16))) unsigned char lds[];
    cg::grid_group grid = cg::this_grid();
    LAS unsigned char* ldsg = (LAS unsigned char*)lds;
    unsigned char* ws = P.ws;
    const int lo = P.ph_lo, hi = P.ph_hi, G = gridDim.x, bx = blockIdx.x;
    volatile LAS unsigned* MISC = (volatile LAS unsigned*)(ldsg + 131072 + 1024);
    if (threadIdx.x < 2) MISC[threadIdx.x] = 0u;
    __syncthreads();
    XcdBarrier xbar = xcd_barrier_post((unsigned*)(ws + WS_BAR), MISC);
    if (hi > NPHASE) grid.sync();
#ifndef PHMASK
#define PHMASK 0x3ff
#endif
#define IN(k) (((PHMASK >> (k)) & 1) && lo <= (k) && (k) < hi)
#ifndef REPMASK
#define REPMASK 0
#endif
#define REP(k) for (int rep_ = 0; rep_ < 1 + ((REPMASK >> (k)) & 1); ++rep_)
#define SEAM(k) do { if (IN(k) && IN((k) + 1)) { xcd_barrier(xbar); if ((REPMASK >> 12) & 1) xcd_barrier(xbar); } } while (0)
    bf16_t* Z = (bf16_t*)(ws + WS_Z); float* SS = (float*)(ws + WS_SS);
    float* SSQ = SS, *SSKV = SS + NTOK, *SS2 = SS + 2 * NTOK, *SS3 = SS + 3 * NTOK;
    if (IN(0)) REP(0) { phase0(P, lds); __syncthreads(); } SEAM(0);
    if (IN(1)) {
        pg8::Gemm g{(const bf16_t*)(ws + WS_U), (const bf16_t*)(ws + WS_WIN), NTOK, NIN, 1024, 1024, 1024}; pg8::StaticOrder S; S.init(NTOK, NIN, G, bx);
        REP(1) { EpiZ E{Z, rep_ ? SS + 4 * NTOK : SSQ, rep_ ? SS + 5 * NTOK : SSKV, (bf16_t*)(ws + WS_RB), (bf16_t*)(ws + WS_SB)};
        pg8::gemm_phase<EpiZ, pg8::StaticOrder, true, true>(ldsg, g, S, E); }
        { const int nfull = (NTOK / 256) * (NIN / 256) % G;
          if (nfull == 0) weight_items(P, lds, NITEMS_EARLY, NITEMS, bx * 8 + (threadIdx.x >> 6), G * 8);
          else if (bx >= nfull) weight_items(P, lds, NITEMS_EARLY, NITEMS, (bx - nfull) * 8 + (threadIdx.x >> 6), (G - nfull) * 8); }
    } SEAM(1);
    if (IN(2)) {
#ifndef NO_P2KV
        REP(11) { pg8::Gemm g{Z + ZC_CKV, (const bf16_t*)(ws + WS_WUKV), NTOK, 1024, 256, ZP, 256}; pg8::StaticOrder S; S.init(NTOK, 1024, G, bx);
          EpiRowScale E{(bf16_t*)(ws + WS_KV), 1024, SSKV, 1.0f / 256.0f, 1.0f};
          pg8::gemm_phase<EpiRowScale, pg8::StaticOrder, true, true>(ldsg, g, S, E); }
#endif
#ifndef NO_P2Q
        REP(13) { pg8::Gemm g{Z + ZC_CQ, (const bf16_t*)(ws + WS_WUQ), NTOK, 768, 384, ZP, 384}; pg8::StaticOrder S; S.init(NTOK, 768, G, (bx + 64) % G);
          EpiRowScale E{(bf16_t*)(ws + WS_U), 768, SSQ, 1.0f / 384.0f, QSCALE};
          pg8::gemm_phase<EpiRowScale, pg8::StaticOrder, true, true>(ldsg, g, S, E); }
#endif
        __syncthreads();
        REP(2) {
#ifndef NO_P2KR
        { const int gt = bx * NTHREADS + threadIdx.x, NGT = G * NTHREADS; bf16_t* KR = (bf16_t*)(ws + WS_KR); const float* cs = (const float*)(ws + WS_COS); const float* sn = (const float*)(ws + WS_SIN);
          for (int e = gt; e < NTOK * 16; e += NGT) { const int row = e >> 4, i = e & 15; const float x1 = bf2f(Z[(size_t)row * ZP + ZC_KR + i]), x2 = bf2f(Z[(size_t)row * ZP + ZC_KR + 16 + i]), c = cs[e], s = sn[e];
              const unsigned pv = pk2(x1 * c - x2 * s, x2 * c + x1 * s); KR[row * 32 + i] = (bf16_t)(pv & 0xffffu); KR[row * 32 + 16 + i] = (bf16_t)(pv >> 16); } }
#endif
#ifndef NO_P2GLA
        { GlaARaw raw; const bf16_t* Zg = Z; const int tid = threadIdx.x, lane = tid & 63, w = __builtin_amdgcn_readfirstlane(tid >> 6);
          if (bx < 1024) GLA_A_LOAD(bx, raw);
          for (int u = bx; u < 1024; u += G) gla_a_unit(P, u, u + G, u + G < 1024, lds, raw); }
#endif
        }
    } SEAM(2);
    if (IN(3)) {
        const int vcu = (G % 8 == 0) ? (bx % 8) * (G / 8) + bx / 8 : bx;
        REP(3) for (int pr = vcu; pr < 256; pr += G) { const int bh = pr >> 2, s = pr & 3; attn_unit(P, bh >> 3, bh & 7, 7 - s, lds); attn_unit(P, bh >> 3, bh & 7, s, lds); }
        gla_scan(P);
    } SEAM(3);
    if (IN(4)) { GlaCRaw raw; const bf16_t* Zg = Z; const float* BCg = (const float*)(ws + WS_OM); const int tid = threadIdx.x, lane = tid & 63, w = __builtin_amdgcn_readfirstlane(tid >> 6);
        const int r32 = lane & 31, hi = lane >> 5, ih = w & 1, eb = w >> 1;
        const float gn = P.gla_norm[32 * eb + r32];
        if (bx < 1024) GLA_C_LOAD(bx, raw);
        for (int u = bx; u < 1024; u += G) gla_c_unit(P, u, u + G, u + G < 1024, lds, raw, gn); } SEAM(4);
    if (IN(5)) {
        pg8::Gemm g{(const bf16_t*)P.out + 16 * MiB / 2, (const bf16_t*)(ws + WS_WOA), NTOK, 1024, 512, 1024, 1024}; pg8::StaticOrder S; S.init(NTOK, 1024, G, bx);
        EpiMix2 E{(bf16_t*)(ws + WS_U), (const bf16_t*)(ws + WS_RB), (const bf16_t*)(ws + WS_SB)}; pg8::gemm_phase<EpiMix2, pg8::StaticOrder, true, true, true>(ldsg, g, S, E);
    } SEAM(5);
    if (IN(6)) {
        pg8::Gemm g{(const bf16_t*)(ws + WS_U), (const bf16_t*)(ws + WS_WOUT), NTOK, 1024, 1024, 1024, 1024}; pg8::StaticOrder S; S.init(NTOK, 1024, G, bx);
        REP(6) { EpiRes<true> E{P.x, P.out, (bf16_t*)(ws + WS_KV), rep_ ? SS + 4 * NTOK : SS2}; pg8::gemm_phase<EpiRes<true>, pg8::StaticOrder, true, true>(ldsg, g, S, E); }
    } SEAM(6);
    if (IN(7)) REP(7) {
        pg8::Gemm g{(const bf16_t*)(ws + WS_KV), (const bf16_t*)(ws + WS_WGU), NTOK, 2 * DFF, 1024, 1024, 1024}; pg8::StaticOrder S; S.init(NTOK, 2 * DFF, G, bx);
        EpiFfn E{(bf16_t*)(ws + WS_Z), SS2}; pg8::gemm_phase<EpiFfn, pg8::StaticOrder, true, true>(ldsg, g, S, E);
    } SEAM(7);
    if (IN(8)) {
        pg8::Gemm g{(const bf16_t*)(ws + WS_Z), (const bf16_t*)(ws + WS_WD), NTOK, 1024, DFF, DFF, DFF}; pg8::StaticOrder S; S.init(NTOK, 1024, G, bx);
        EpiResNorm E{(const bf16_t*)(ws + WS_KV), P.out, SS3, P.final_norm, (unsigned*)(ws + WS_BAR + 16384), xbar.bar};
        pg8::gemm_phase<EpiResNorm, pg8::StaticOrder, false, true>(ldsg, g, S, E);
    }
#undef IN
#undef SEAM
}

#ifndef N_LAUNCHES
#define N_LAUNCHES 1
#endif
extern "C" void kernel_launch(void* const* d_in, const int* in_sizes, int n_in, void* d_out, int out_size, void* d_ws, size_t ws_size, hipStream_t stream) {
    static int grid = 0;
    if (grid == 0) {
        if (n_in != 19 || out_size != NTOK * DM || ws_size < WS_END) { fprintf(stderr, "kernel_launch: unexpected shapes (n_in %d out %d ws %zu)\n", n_in, out_size, ws_size); grid = -1; return; }
        int dev = 0, cus = 0, per_cu = 0;
        (void)hipGetDevice(&dev); (void)hipDeviceGetAttribute(&cus, hipDeviceAttributeMultiprocessorCount, dev);
        if (hipFuncSetAttribute((const void*)hybrid_fwd, hipFuncAttributeMaxDynamicSharedMemorySize, LDS_BYTES) != hipSuccess) { fprintf(stderr, "kernel_launch: hipFuncSetAttribute failed\n"); grid = -1; return; }
        if (hipOccupancyMaxActiveBlocksPerMultiprocessor(&per_cu, (const void*)hybrid_fwd, NTHREADS, LDS_BYTES) != hipSuccess || per_cu < 1) { fprintf(stderr, "kernel_launch: occupancy query says %d\n", per_cu); per_cu = 1; }
        (void)hipGetLastError();
        grid = cus * 1;
        if (grid != 256) { fprintf(stderr, "kernel_launch: built for a 256-CU device (one 256x256 unit per workgroup in the last phase); got %d CUs\n", grid); grid = -1; return; }
    }
    if (grid < 0) return;
    Params p{};
    p.x = (const float*)d_in[0]; p.pos = (const int*)d_in[1]; p.ln_mix = (const float*)d_in[2]; p.w_in = (const float*)d_in[3]; p.norm_cq = (const float*)d_in[4]; p.w_uq = (const float*)d_in[5];
    p.norm_ckv = (const float*)d_in[6]; p.w_ukv = (const float*)d_in[7]; p.w_oa = (const float*)d_in[8]; p.w_gate2 = (const float*)d_in[9]; p.b_gate = (const float*)d_in[10]; p.gla_norm = (const float*)d_in[11];
    p.w_ob = (const float*)d_in[12]; p.w_out = (const float*)d_in[13]; p.ln_ffn = (const float*)d_in[14]; p.w_fg = (const float*)d_in[15]; p.w_fu = (const float*)d_in[16]; p.w_fd = (const float*)d_in[17]; p.final_norm = (const float*)d_in[18];
    p.out = (float*)d_out; p.ws = (unsigned char*)d_ws;
    (void)hipMemsetAsync((char*)d_ws + WS_BAR, 0, 32768, stream);
#if N_LAUNCHES == 1
    p.ph_lo = 0; p.ph_hi = NPHASE;
    void* args[] = {&p};
    hipError_t e = hipLaunchCooperativeKernel((const void*)hybrid_fwd, dim3(grid), dim3(NTHREADS), args, LDS_BYTES, stream);
    if (e != hipSuccess) fprintf(stderr, "cooperative launch failed: %s (grid %d)\n", hipGetErrorString(e), grid);
#else
    for (int ph = 0; ph < NPHASE; ++ph) { p.ph_lo = ph; p.ph_hi = ph + 1; hipLaunchKernelGGL(hybrid_fwd, dim3(grid), dim3(NTHREADS), LDS_BYTES, stream, p); }
#endif
}
```
